# Optimizing an MI355X kernel written in HIP

```python
import jax, jax.numpy as jnp
from jax import lax
import numpy as np

D_MODEL = 1024
BATCH = 4
SEQ = 8192
DEPTH = 1
DEC_BATCH = 8
DEC_SEQ = 64
PAST_LEN = 1024

CHUNK = 64
HEAD_DIM = 64
H_A = 8
H_B = 8
H_IDX = 8
D_IDX = 64
ROT_DIM = HEAD_DIM // 4
ROPE_THETA = 500000.0
TOPK_MAX = 256
BAND_CHUNKS = 8
BAND_ROWS = BAND_CHUNKS * CHUNK
REL_CLIP = 128
D_FF = 4 * D_MODEL
Q_BLOCK = 128
EPS = 1e-6
ATTN_SCALE = HEAD_DIM ** -0.5

W_A = H_A * HEAD_DIM
W_B = H_B * HEAD_DIM
SPLITS = [W_A, W_A, W_A, H_IDX * D_IDX, D_IDX, H_IDX, W_B, W_B, W_B, D_MODEL, D_MODEL]
SPLIT_POINTS = [sum(SPLITS[:i + 1]) for i in range(len(SPLITS) - 1)]
D_IN = sum(SPLITS)

kernel_name = 'hybrid_streaming_dsa_chunkband_step'


def rmsnorm(x, g):
    xf = x.astype(jnp.float32)
    y = xf * lax.rsqrt(jnp.mean(xf * xf, axis=-1, keepdims=True) + EPS)
    return (y * g.astype(jnp.float32)).astype(x.dtype)


def partial_rope(x, pos):
    half = ROT_DIM // 2
    inv = ROPE_THETA ** (-jnp.arange(half, dtype=jnp.float32) / half)
    ang = pos.astype(jnp.float32)[:, None] * inv[None, :]
    shape = (pos.shape[0],) + (1,) * (x.ndim - 3) + (half,)
    cos = jnp.cos(ang).reshape(shape).astype(x.dtype)
    sin = jnp.sin(ang).reshape(shape).astype(x.dtype)
    x1 = x[..., :half]
    x2 = x[..., half:ROT_DIM]
    return jnp.concatenate([x1 * cos - x2 * sin, x2 * cos + x1 * sin, x[..., ROT_DIM:]], axis=-1)


def rel_bias(table, dist):
    b = table[jnp.clip(dist, -REL_CLIP, REL_CLIP) + REL_CLIP]
    return jnp.moveaxis(b, -1, 0).astype(jnp.float32)


def mixer_inputs(xn, pos, w_in, qnorm_a, knorm_a, knorm_idx, qnorm_b, knorm_b):
    B, T, _ = xn.shape
    z = xn @ w_in
    qa, ka, va, qi, ki, wi, qb, kb, vb, ga, gb = jnp.split(z, SPLIT_POINTS, axis=-1)
    qa = partial_rope(rmsnorm(qa.reshape(B, T, H_A, HEAD_DIM), qnorm_a), pos)
    ka = partial_rope(rmsnorm(ka.reshape(B, T, H_A, HEAD_DIM), knorm_a), pos)
    va = va.reshape(B, T, H_A, HEAD_DIM)
    qi = partial_rope(qi.reshape(B, T, H_IDX, D_IDX), pos)
    ki = partial_rope(rmsnorm(ki, knorm_idx), pos)
    qb = rmsnorm(qb.reshape(B, T, H_B, HEAD_DIM), qnorm_b)
    kb = rmsnorm(kb.reshape(B, T, H_B, HEAD_DIM), knorm_b)
    vb = vb.reshape(B, T, H_B, HEAD_DIM)
    return qa, ka, va, qi, ki, wi, qb, kb, vb, jax.nn.sigmoid(ga), jax.nn.sigmoid(gb)


def dsa_attention(qa, ka_all, va_all, qi, ki_all, wi, q_pos, k_pos, topk):
    B, T = qa.shape[:2]
    qb = Q_BLOCK if T % Q_BLOCK == 0 else T
    nb = T // qb
    k_chunk = k_pos // CHUNK

    def block(args):
        q, q_i, w, qp = args
        s = jax.nn.relu(jnp.einsum('bqhd,bsd->bqhs', q_i, ki_all))
        isc = jnp.einsum('bqh,bqhs->bqs', w, s).astype(jnp.float32)
        q_chunk = qp // CHUNK
        vis = k_chunk[None, :] <= q_chunk[:, None]
        isc = jnp.where(vis[None], isc, -jnp.inf)
        _, idx = lax.top_k(isc, topk)
        k_sel = jax.vmap(lambda kk, ii: kk[ii])(ka_all, idx)
        v_sel = jax.vmap(lambda vv, ii: vv[ii])(va_all, idx)
        ok = k_chunk[idx] <= q_chunk[None, :, None]
        logits = jnp.einsum('bqhd,bqkhd->bhqk', q, k_sel).astype(jnp.float32) * ATTN_SCALE
        logits = jnp.where(ok[:, None], logits, -jnp.inf)
        p = jax.nn.softmax(logits, axis=-1).astype(v_sel.dtype)
        return jnp.einsum('bhqk,bqkhd->bqhd', p, v_sel)

    def blocks(a):
        return jnp.moveaxis(a.reshape((B, nb, qb) + a.shape[2:]), 1, 0)

    out = lax.map(block, (blocks(qa), blocks(qi), blocks(wi), q_pos.reshape(nb, qb)))
    return jnp.moveaxis(out, 0, 1).reshape(B, T, H_A, HEAD_DIM)


def band_attention_prompt(q, k, v, table):
    B, T, H, D = q.shape
    nc = T // CHUNK
    nbnd = BAND_CHUNKS + 1
    qc = q.reshape(B, nc, CHUNK, H, D)
    pad = jnp.zeros((B, BAND_CHUNKS, CHUNK, H, D), k.dtype)
    kp = jnp.concatenate([pad, k.reshape(B, nc, CHUNK, H, D)], axis=1)
    vp = jnp.concatenate([pad, v.reshape(B, nc, CHUNK, H, D)], axis=1)
    band_idx = jnp.arange(nc)[:, None] + jnp.arange(nbnd)[None, :]
    kband = kp[:, band_idx].reshape(B, nc, nbnd * CHUNK, H, D)
    vband = vp[:, band_idx].reshape(B, nc, nbnd * CHUNK, H, D)
    i = jnp.arange(CHUNK)
    s_rel = ((jnp.arange(nbnd)[:, None] - BAND_CHUNKS) * CHUNK + i[None, :]).reshape(-1)
    bias = rel_bias(table, i[:, None] - s_rel[None, :])
    key_ok = jnp.repeat(band_idx >= BAND_CHUNKS, CHUNK, axis=1)
    logits = jnp.einsum('bcqhd,bckhd->bchqk', qc, kband).astype(jnp.float32) * ATTN_SCALE + bias[None, None]
    logits = jnp.where(key_ok[None, :, None, None, :], logits, -jnp.inf)
    p = jax.nn.softmax(logits, axis=-1).astype(vband.dtype)
    return jnp.einsum('bchqk,bckhd->bcqhd', p, vband).reshape(B, T, H, D)


def band_attention_sample(q, k_all, v_all, q_pos, k_pos, table):
    bias = rel_bias(table, q_pos[:, None] - k_pos[None, :])
    logits = jnp.einsum('bqhd,bkhd->bhqk', q, k_all).astype(jnp.float32) * ATTN_SCALE + bias[None]
    p = jax.nn.softmax(logits, axis=-1).astype(v_all.dtype)
    return jnp.einsum('bhqk,bkhd->bqhd', p, v_all)


def merge_and_ffn(x, oa, ob, ga, gb, w_o_a, w_o_b, w_out, norm_ffn, w_up, w_down):
    B, T, _ = x.shape
    m = ga * (oa.reshape(B, T, W_A) @ w_o_a) + gb * (ob.reshape(B, T, W_B) @ w_o_b)
    x = x + m @ w_out
    h = jnp.square(jax.nn.relu(rmsnorm(x, norm_ffn) @ w_up))
    return x + h @ w_down


def setup_inputs(seed: int = 0) -> dict:
    key = jax.random.key(seed)
    ks = jax.random.split(key, 24)
    f32 = jnp.float32

    def nrm(k, shape, scale=1.0):
        return jax.random.normal(k, shape, f32) * scale

    def gain(k, n):
        return 1.0 + 0.01 * jax.random.normal(k, (DEPTH, n), f32)

    rows_b = min(BAND_ROWS, PAST_LEN)
    return {
        'x_prompt': nrm(ks[0], (BATCH, SEQ, D_MODEL)),
        'x_sample': nrm(ks[1], (DEC_BATCH, DEC_SEQ, D_MODEL)),
        'cache_k_a': nrm(ks[2], (DEPTH, DEC_BATCH, PAST_LEN, H_A, HEAD_DIM)),
        'cache_v_a': nrm(ks[3], (DEPTH, DEC_BATCH, PAST_LEN, H_A, HEAD_DIM)),
        'cache_k_idx': nrm(ks[4], (DEPTH, DEC_BATCH, PAST_LEN, D_IDX)),
        'cache_k_b': nrm(ks[5], (DEPTH, DEC_BATCH, rows_b, H_B, HEAD_DIM)),
        'cache_v_b': nrm(ks[6], (DEPTH, DEC_BATCH, rows_b, H_B, HEAD_DIM)),
        'norm_mix': gain(ks[7], D_MODEL),
        'w_in': nrm(ks[8], (DEPTH, D_MODEL, D_IN), D_MODEL ** -0.5),
        'qnorm_a': gain(ks[9], HEAD_DIM),
        'knorm_a': gain(ks[10], HEAD_DIM),
        'knorm_idx': gain(ks[11], D_IDX),
        'qnorm_b': gain(ks[12], HEAD_DIM),
        'knorm_b': gain(ks[13], HEAD_DIM),
        'rel_bias_b': nrm(ks[14], (DEPTH, 2 * REL_CLIP + 1, H_B), 0.5),
        'w_o_a': nrm(ks[15], (DEPTH, W_A, D_MODEL), W_A ** -0.5),
        'w_o_b': nrm(ks[16], (DEPTH, W_B, D_MODEL), W_B ** -0.5),
        'w_out': nrm(ks[17], (DEPTH, D_MODEL, D_MODEL), D_MODEL ** -0.5),
        'norm_ffn': gain(ks[18], D_MODEL),
        'w_up': nrm(ks[19], (DEPTH, D_MODEL, D_FF), D_MODEL ** -0.5),
        'w_down': nrm(ks[20], (DEPTH, D_FF, D_MODEL), D_FF ** -0.5),
    }


def reference(x_prompt, x_sample, cache_k_a, cache_v_a, cache_k_idx, cache_k_b, cache_v_b,
              norm_mix, w_in, qnorm_a, knorm_a, knorm_idx, qnorm_b, knorm_b, rel_bias_b,
              w_o_a, w_o_b, w_out, norm_ffn, w_up, w_down):
    T = x_prompt.shape[1]
    Ts = x_sample.shape[1]
    past = cache_k_a.shape[2]
    rows_b = cache_k_b.shape[2]
    pos_p = jnp.arange(T, dtype=jnp.int32)
    pos_s = past + jnp.arange(Ts, dtype=jnp.int32)
    kpos_a_s = jnp.arange(past + Ts, dtype=jnp.int32)
    kpos_b_s = jnp.arange(past - rows_b, past + Ts, dtype=jnp.int32)
    topk_p = min(TOPK_MAX, T // 4)
    topk_s = min(TOPK_MAX, (past + Ts) // 4)
    keep_p = min(BAND_ROWS, T)

    xp, xs = x_prompt, x_sample
    ka_p, va_p, ki_p, kb_p, vb_p = [], [], [], [], []
    ka_s, va_s, ki_s, kb_s, vb_s = [], [], [], [], []
    for l in range(DEPTH):
        norms = (qnorm_a[l], knorm_a[l], knorm_idx[l], qnorm_b[l], knorm_b[l])
        outw = (w_o_a[l], w_o_b[l], w_out[l], norm_ffn[l], w_up[l], w_down[l])
        qa, ka, va, qi, ki, wi, qb, kb, vb, ga, gb = mixer_inputs(rmsnorm(xp, norm_mix[l]), pos_p, w_in[l], *norms)
        oa = dsa_attention(qa, ka, va, qi, ki, wi, pos_p, pos_p, topk_p)
        ob = band_attention_prompt(qb, kb, vb, rel_bias_b[l])
        xp = merge_and_ffn(xp, oa, ob, ga, gb, *outw)
        ka_p.append(ka); va_p.append(va); ki_p.append(ki)
        kb_p.append(kb[:, T - keep_p:]); vb_p.append(vb[:, T - keep_p:])
        qa, ka, va, qi, ki, wi, qb, kb, vb, ga, gb = mixer_inputs(rmsnorm(xs, norm_mix[l]), pos_s, w_in[l], *norms)
        oa = dsa_attention(qa, jnp.concatenate([cache_k_a[l], ka], axis=1),
                           jnp.concatenate([cache_v_a[l], va], axis=1), qi,
                           jnp.concatenate([cache_k_idx[l], ki], axis=1), wi, pos_s, kpos_a_s, topk_s)
        ob = band_attention_sample(qb, jnp.concatenate([cache_k_b[l], kb], axis=1),
                                   jnp.concatenate([cache_v_b[l], vb], axis=1), pos_s, kpos_b_s, rel_bias_b[l])
        xs = merge_and_ffn(xs, oa, ob, ga, gb, *outw)
        ka_s.append(ka); va_s.append(va); ki_s.append(ki); kb_s.append(kb); vb_s.append(vb)

    return (xp, xs,
            jnp.stack(ka_p), jnp.stack(va_p), jnp.stack(ki_p), jnp.stack(kb_p), jnp.stack(vb_p),
            jnp.stack(ka_s), jnp.stack(va_s), jnp.stack(ki_s), jnp.stack(kb_s), jnp.stack(vb_s))
```

```cpp
#include <hip/hip_runtime.h>
#include <hip/hip_cooperative_groups.h>
#include <stdint.h>
#include <cstdio>
namespace cg = cooperative_groups;

typedef __attribute__((ext_vector_type(8))) short bf16x8;
typedef __attribute__((ext_vector_type(16))) float f32x16;
typedef __attribute__((ext_vector_type(4))) float f32x4;
typedef unsigned short u16;
typedef unsigned long long u64;

#ifndef MULTI_LAUNCH
#define MULTI_LAUNCH 1
#endif

#define NTOK 33280
#define NPROMPT 32768
#define DM 1024
#define DFF 4096
#define NIN 5760
#define LOG2E 1.4426950408889634f

constexpr size_t AL(size_t x) { return (x + 255) & ~(size_t)255; }
constexpr size_t OFF_WIN = 0;
constexpr size_t OFF_WOA = OFF_WIN + AL((size_t)NIN * 1024 * 2);
constexpr size_t OFF_WOB = OFF_WOA + AL((size_t)1024 * 512 * 2);
constexpr size_t OFF_WOUT = OFF_WOB + AL((size_t)1024 * 512 * 2);
constexpr size_t OFF_WUP = OFF_WOUT + AL((size_t)1024 * 1024 * 2);
constexpr size_t OFF_WDN = OFF_WUP + AL((size_t)4096 * 1024 * 2);
constexpr size_t OFF_CS = OFF_WDN + AL((size_t)4096 * 1024 * 2);
constexpr size_t OFF_ROWSS = OFF_CS + AL((size_t)8192 * 8 * 8);
constexpr size_t OFF_XN = OFF_ROWSS + AL((size_t)NTOK * 4);
constexpr size_t OFF_MASKP = OFF_XN;
constexpr size_t OFF_MASKS = OFF_MASKP + (size_t)NPROMPT * 128 * 8;
constexpr size_t OFF_X1B = OFF_XN;
constexpr size_t OFF_Z = OFF_XN + AL((size_t)NTOK * 1024 * 2);
constexpr size_t OFF_QA = OFF_Z;
constexpr size_t OFF_QB = OFF_QA + AL((size_t)NTOK * 512 * 2);
constexpr size_t OFF_QI = OFF_QB + AL((size_t)NTOK * 512 * 2);
constexpr size_t OFF_GA = OFF_QI + AL((size_t)NTOK * 512 * 2);
constexpr size_t OFF_GB = OFF_GA + AL((size_t)NTOK * 1024 * 2);
constexpr size_t OFF_WI = OFF_GB + AL((size_t)NTOK * 1024 * 2);
constexpr size_t OFF_KAP = OFF_WI + AL((size_t)NTOK * 8 * 4);
constexpr size_t OFF_KAS = OFF_KAP + AL((size_t)4 * 8 * 8192 * 64 * 2);
constexpr size_t OFF_VAP = OFF_KAS + AL((size_t)8 * 8 * 1088 * 64 * 2);
constexpr size_t OFF_VAS = OFF_VAP + AL((size_t)4 * 8 * 8192 * 64 * 2);
constexpr size_t OFF_KIP = OFF_VAS + AL((size_t)8 * 8 * 1088 * 64 * 2);
constexpr size_t OFF_KIS = OFF_KIP + AL((size_t)4 * 8192 * 64 * 2);
constexpr size_t OFF_KBP = OFF_KIS + AL((size_t)8 * 1088 * 64 * 2);
constexpr size_t OFF_KBS = OFF_KBP + AL((size_t)4 * 8 * 8192 * 64 * 2);
constexpr size_t OFF_VBP = OFF_KBS + AL((size_t)8 * 8 * 576 * 64 * 2);
constexpr size_t OFF_VBS = OFF_VBP + AL((size_t)4 * 8 * 8192 * 64 * 2);
constexpr size_t OFF_END = OFF_VBS + AL((size_t)8 * 8 * 576 * 64 * 2);
constexpr size_t OFF_M = OFF_KAP;
constexpr size_t OFF_H = OFF_Z;
static_assert(OFF_MASKS + (size_t)512 * 32 * 8 <= OFF_Z, "mask overlay");
static_assert(OFF_M + (size_t)NTOK * 1024 * 2 <= OFF_END, "M overlay");
static_assert(OFF_H + (size_t)NTOK * 4096 * 2 <= OFF_END, "H overlay");
static_assert(OFF_END <= (size_t)512 * 1024 * 1024, "ws budget");

constexpr size_t O_Y = 0;
constexpr size_t O_KAP = (size_t)NTOK * 1024;
constexpr size_t O_VAP = O_KAP + (size_t)4 * 8192 * 512;
constexpr size_t O_KIP = O_VAP + (size_t)4 * 8192 * 512;
constexpr size_t O_KBP = O_KIP + (size_t)4 * 8192 * 64;
constexpr size_t O_VBP = O_KBP + (size_t)4 * 512 * 512;
constexpr size_t O_KAS = O_VBP + (size_t)4 * 512 * 512;
constexpr size_t O_VAS = O_KAS + (size_t)8 * 64 * 512;
constexpr size_t O_KIS = O_VAS + (size_t)8 * 64 * 512;
constexpr size_t O_KBS = O_KIS + (size_t)8 * 64 * 64;
constexpr size_t O_VBS = O_KBS + (size_t)8 * 64 * 512;

struct Params {
  const float* in[21];
  float* out;
  unsigned char* ws;
};

__device__ __forceinline__ u16 f2bf(float f) {
  uint32_t u = __float_as_uint(f);
  u += 0x7FFFu + ((u >> 16) & 1u);
  return (u16)(u >> 16);
}
__device__ __forceinline__ uint32_t pack2(float a, float b) {
  return (uint32_t)f2bf(a) | ((uint32_t)f2bf(b) << 16);
}
__device__ __forceinline__ float bf2f(u16 v) { return __uint_as_float(((uint32_t)v) << 16); }
__device__ __forceinline__ float bflo(uint32_t v) { return __uint_as_float(v << 16); }
__device__ __forceinline__ float bfhi(uint32_t v) { return __uint_as_float(v & 0xFFFF0000u); }
__device__ __forceinline__ f32x16 mfma32(bf16x8 a, bf16x8 b, f32x16 c) {
  return __builtin_amdgcn_mfma_f32_32x32x16_bf16(a, b, c, 0, 0, 0);
}
__device__ __forceinline__ f32x4 mfma16(bf16x8 a, bf16x8 b, f32x4 c) {
  return __builtin_amdgcn_mfma_f32_16x16x32_bf16(a, b, c, 0, 0, 0);
}
__device__ __forceinline__ bf16x8 as_bf8(uint4 v) {
  union { uint4 u; bf16x8 b; } x; x.u = v; return x.b;
}
__device__ __forceinline__ const float* xrow(const Params& p, int token) {
  return token < NPROMPT ? p.in[0] + (size_t)token * 1024 : p.in[1] + (size_t)(token - NPROMPT) * 1024;
}

#define SMEM_BYTES 131072

struct GemmSmem { u16 A[128][72]; u16 B[256][72]; };

template <int KTOT>
__device__ __forceinline__ void gemm_kloop(const u16* __restrict__ Ag, int lda, const u16* __restrict__ Bg, int ldb,
                                           f32x16 (&acc)[2][2], GemmSmem& sm, int tid) {
  const int lane = tid & 63, wave = tid >> 6;
  const int wf = wave & 1, wt = wave >> 1;
  const int r = lane & 31, h = lane >> 5;
  constexpr int KT = KTOT / 64;
  const int crow = tid >> 3, ccol = (tid & 7) * 8;
  const u16* ap = Ag + (size_t)crow * lda + ccol;
  const u16* bp = Bg + (size_t)crow * ldb + ccol;
  const size_t as64 = (size_t)64 * lda, bs64 = (size_t)64 * ldb;
  uint4 ra0 = *(const uint4*)(ap), ra1 = *(const uint4*)(ap + as64);
  uint4 rb0 = *(const uint4*)(bp), rb1 = *(const uint4*)(bp + bs64), rb2 = *(const uint4*)(bp + 2 * bs64), rb3 = *(const uint4*)(bp + 3 * bs64);
  for (int kt = 0; kt < KT; kt++) {
    *(uint4*)&sm.A[crow][ccol] = ra0;
    *(uint4*)&sm.A[crow + 64][ccol] = ra1;
    *(uint4*)&sm.B[crow][ccol] = rb0;
    *(uint4*)&sm.B[crow + 64][ccol] = rb1;
    *(uint4*)&sm.B[crow + 128][ccol] = rb2;
    *(uint4*)&sm.B[crow + 192][ccol] = rb3;
    __syncthreads();
    if (kt + 1 < KT) {
      ap += 64; bp += 64;
      ra0 = *(const uint4*)(ap); ra1 = *(const uint4*)(ap + as64);
      rb0 = *(const uint4*)(bp); rb1 = *(const uint4*)(bp + bs64); rb2 = *(const uint4*)(bp + 2 * bs64); rb3 = *(const uint4*)(bp + 3 * bs64);
    }
#pragma unroll
    for (int kk = 0; kk < 4; kk++) {
      bf16x8 a0 = *(const bf16x8*)&sm.A[wf * 64 + r][kk * 16 + h * 8];
      bf16x8 a1 = *(const bf16x8*)&sm.A[wf * 64 + 32 + r][kk * 16 + h * 8];
      bf16x8 b0 = *(const bf16x8*)&sm.B[wt * 64 + r][kk * 16 + h * 8];
      bf16x8 b1 = *(const bf16x8*)&sm.B[wt * 64 + 32 + r][kk * 16 + h * 8];
      acc[0][0] = mfma32(a0, b0, acc[0][0]);
      acc[0][1] = mfma32(a0, b1, acc[0][1]);
      acc[1][0] = mfma32(a1, b0, acc[1][0]);
      acc[1][1] = mfma32(a1, b1, acc[1][1]);
    }
    __syncthreads();
  }
}

__device__ __forceinline__ void zero_acc(f32x16 (&acc)[2][2]) {
#pragma unroll
  for (int a = 0; a < 2; a++)
#pragma unroll
    for (int b = 0; b < 2; b++)
#pragma unroll
      for (int i = 0; i < 16; i++) acc[a][b][i] = 0.f;
}

__device__ void tconv_tile(const float* __restrict__ src, int ldsrc, int k0, int nsrc0, int nvalid,
                           u16* __restrict__ dst, int K, int ndst0, const float* __restrict__ gain, float* sm, int tid) {
  const int nl = tid & 63, kl0 = tid >> 6;
#pragma unroll
  for (int i = 0; i < 8; i++) {
    int kl = kl0 + 8 * i;
    float v = 0.f;
    if (nl < nvalid) {
      v = src[(size_t)(k0 + kl) * ldsrc + nsrc0 + nl];
      if (gain) v *= gain[k0 + kl];
    }
    sm[kl * 65 + nl] = v;
  }
  __syncthreads();
  const int kl = tid & 63, nl0 = tid >> 6;
#pragma unroll
  for (int i = 0; i < 8; i++) {
    int n = nl0 + 8 * i;
    dst[(size_t)(ndst0 + n) * K + k0 + kl] = f2bf(sm[kl * 65 + n]);
  }
  __syncthreads();
}

__device__ __forceinline__ int inproj_src_col(int g) {
  if (g < 33) return g * 64;
  if (g < 89) return 2120 + (g - 33) * 64;
  return 2112;
}

__device__ void phase0(const Params& p, unsigned char* smem) {
  const int tid = threadIdx.x;
  unsigned char* ws = p.ws;
  float* smf = (float*)smem;
  const int NT_IN = 90 * 16, NT_OA = 16 * 8, NT_OUT = 16 * 16, NT_UP = 64 * 16, NT_DN = 16 * 64;
  const int total = NT_IN + 2 * NT_OA + NT_OUT + NT_UP + NT_DN;
  for (int t = blockIdx.x; t < total; t += gridDim.x) {
    int u = t;
    if (u < NT_IN) {
      int g = u / 16, kb = u % 16;
      tconv_tile(p.in[8], 5704, kb * 64, inproj_src_col(g), g == 89 ? 8 : 64, (u16*)(ws + OFF_WIN), 1024, g * 64, nullptr, smf, tid);
      continue;
    }
    u -= NT_IN;
    if (u < NT_OA) { int g = u / 8, kb = u % 8; tconv_tile(p.in[15], 1024, kb * 64, g * 64, 64, (u16*)(ws + OFF_WOA), 512, g * 64, nullptr, smf, tid); continue; }
    u -= NT_OA;
    if (u < NT_OA) { int g = u / 8, kb = u % 8; tconv_tile(p.in[16], 1024, kb * 64, g * 64, 64, (u16*)(ws + OFF_WOB), 512, g * 64, nullptr, smf, tid); continue; }
    u -= NT_OA;
    if (u < NT_OUT) { int g = u / 16, kb = u % 16; tconv_tile(p.in[17], 1024, kb * 64, g * 64, 64, (u16*)(ws + OFF_WOUT), 1024, g * 64, nullptr, smf, tid); continue; }
    u -= NT_OUT;
    if (u < NT_UP) { int g = u / 16, kb = u % 16; tconv_tile(p.in[19], 4096, kb * 64, g * 64, 64, (u16*)(ws + OFF_WUP), 1024, g * 64, p.in[18], smf, tid); continue; }
    u -= NT_UP;
    { int g = u / 64, kb = u % 64; tconv_tile(p.in[20], 1024, kb * 64, g * 64, 64, (u16*)(ws + OFF_WDN), 4096, g * 64, nullptr, smf, tid); }
  }
  {
    const int lane = tid & 63, wave = tid >> 6;
    const float* g = p.in[7];
    u16* XN = (u16*)(ws + OFF_XN);
    for (int row = blockIdx.x * 8 + wave; row < NTOK; row += gridDim.x * 8) {
      const float4* xr = (const float4*)xrow(p, row);
      float4 v[4];
      float ss = 0.f;
#pragma unroll
      for (int i = 0; i < 4; i++) {
        v[i] = xr[lane + 64 * i];
        ss += v[i].x * v[i].x + v[i].y * v[i].y + v[i].z * v[i].z + v[i].w * v[i].w;
      }
#pragma unroll
      for (int o = 32; o >= 1; o >>= 1) ss += __shfl_xor(ss, o);
      float rs = rsqrtf(ss * (1.f / 1024.f) + 1e-6f);
#pragma unroll
      for (int i = 0; i < 4; i++) {
        float4 gg = ((const float4*)g)[lane + 64 * i];
        uint2 o;
        o.x = pack2(v[i].x * rs * gg.x, v[i].y * rs * gg.y);
        o.y = pack2(v[i].z * rs * gg.z, v[i].w * rs * gg.w);
        *(uint2*)(XN + (size_t)row * 1024 + (lane + 64 * i) * 4) = o;
      }
    }
  }
  const size_t gtid = (size_t)blockIdx.x * blockDim.x + tid;
  const size_t gsz = (size_t)gridDim.x * blockDim.x;
  {
    float2* CS = (float2*)(ws + OFF_CS);
    for (size_t i = gtid; i < 8192 * 8; i += gsz) {
      int pos = (int)(i >> 3), f = (int)(i & 7);
      float inv = powf(500000.0f, -(float)f / 8.0f);
      float ang = (float)pos * inv;
      double rr = (double)ang;
      rr = rr - 6.283185307179586 * rint(rr * 0.15915494309189535);
      float s, c;
      sincosf((float)rr, &s, &c);
      CS[i] = make_float2(c, s);
    }
    float* rss = (float*)(ws + OFF_ROWSS);
    for (size_t i = gtid; i < NTOK; i += gsz) rss[i] = 0.f;
  }
  {
    u16* KAS = (u16*)(ws + OFF_KAS); u16* VAS = (u16*)(ws + OFF_VAS); u16* KIS = (u16*)(ws + OFF_KIS);
    u16* KBS = (u16*)(ws + OFF_KBS); u16* VBS = (u16*)(ws + OFF_VBS);
    const float* cka = p.in[2]; const float* cva = p.in[3]; const float* cki = p.in[4];
    const float* ckb = p.in[5]; const float* cvb = p.in[6];
    for (size_t i = gtid; i < (size_t)8 * 1024 * 512; i += gsz) {
      int d = (int)(i & 63), hd = (int)((i >> 6) & 7), j = (int)((i >> 9) & 1023), bs = (int)(i >> 19);
      KAS[((size_t)(bs * 8 + hd) * 1088 + j) * 64 + d] = f2bf(cka[i]);
      VAS[((size_t)(bs * 8 + hd) * 64 + d) * 1088 + j] = f2bf(cva[i]);
    }
    for (size_t i = gtid; i < (size_t)8 * 1024 * 64; i += gsz) {
      int d = (int)(i & 63), j = (int)((i >> 6) & 1023), bs = (int)(i >> 16);
      KIS[((size_t)bs * 1088 + j) * 64 + d] = f2bf(cki[i]);
    }
    for (size_t i = gtid; i < (size_t)8 * 512 * 512; i += gsz) {
      int d = (int)(i & 63), hd = (int)((i >> 6) & 7), j = (int)((i >> 9) & 511), bs = (int)(i >> 18);
      KBS[((size_t)(bs * 8 + hd) * 576 + j) * 64 + d] = f2bf(ckb[i]);
      VBS[((size_t)(bs * 8 + hd) * 64 + d) * 576 + j] = f2bf(cvb[i]);
    }
  }
}

__device__ __forceinline__ void epi_inproj(const Params& p, f32x16 (&acc)[2][2], int g, int tbase, int lane) {
  unsigned char* ws = p.ws;
  const int r = lane & 31, h = lane >> 5;
  const bool sample = tbase >= NPROMPT;
  int b, trow;
  if (!sample) { b = tbase >> 13; trow = tbase & 8191; } else { b = (tbase - NPROMPT) >> 6; trow = 0; }
  const float* gain = nullptr; bool rope = false, sig = false;
  u16* bdst = nullptr; size_t brow0 = 0; int bld = 0, bcol = 0;
  u16* vdst = nullptr; int vS = 0, vcol0 = 0;
  float* fdst = nullptr; size_t frow0 = 0; int fld = 0, fcol = 0;
  bool wi = false;
  if (g < 8) { gain = p.in[9]; rope = true; bdst = (u16*)(ws + OFF_QA); brow0 = tbase; bld = 512; bcol = g * 64; }
  else if (g < 16) {
    int hd = g - 8; gain = p.in[10]; rope = true; bld = 64;
    if (!sample) { bdst = (u16*)(ws + OFF_KAP) + (size_t)(b * 8 + hd) * 8192 * 64; brow0 = trow; fdst = p.out + O_KAP; frow0 = tbase; }
    else { bdst = (u16*)(ws + OFF_KAS) + (size_t)(b * 8 + hd) * 1088 * 64; brow0 = 1024; fdst = p.out + O_KAS; frow0 = b * 64; }
    fld = 512; fcol = hd * 64;
  } else if (g < 24) {
    int hd = g - 16;
    if (!sample) { vdst = (u16*)(ws + OFF_VAP) + (size_t)(b * 8 + hd) * 64 * 8192; vS = 8192; vcol0 = trow; fdst = p.out + O_VAP; frow0 = tbase; }
    else { vdst = (u16*)(ws + OFF_VAS) + (size_t)(b * 8 + hd) * 64 * 1088; vS = 1088; vcol0 = 1024; fdst = p.out + O_VAS; frow0 = b * 64; }
    fld = 512; fcol = hd * 64;
  } else if (g < 32) { rope = true; bdst = (u16*)(ws + OFF_QI); brow0 = tbase; bld = 512; bcol = (g - 24) * 64; }
  else if (g == 32) {
    gain = p.in[11]; rope = true; bld = 64; fld = 64;
    if (!sample) { bdst = (u16*)(ws + OFF_KIP) + (size_t)b * 8192 * 64; brow0 = trow; fdst = p.out + O_KIP; frow0 = tbase; }
    else { bdst = (u16*)(ws + OFF_KIS) + (size_t)b * 1088 * 64; brow0 = 1024; fdst = p.out + O_KIS; frow0 = b * 64; }
  } else if (g < 41) { gain = p.in[12]; bdst = (u16*)(ws + OFF_QB); brow0 = tbase; bld = 512; bcol = (g - 33) * 64; }
  else if (g < 49) {
    int hd = g - 41; gain = p.in[13]; bld = 64; fld = 512; fcol = hd * 64;
    if (!sample) {
      bdst = (u16*)(ws + OFF_KBP) + (size_t)(b * 8 + hd) * 8192 * 64; brow0 = trow;
      if (trow >= 7680) { fdst = p.out + O_KBP; frow0 = b * 512 + (trow - 7680); }
    } else { bdst = (u16*)(ws + OFF_KBS) + (size_t)(b * 8 + hd) * 576 * 64; brow0 = 512; fdst = p.out + O_KBS; frow0 = b * 64; }
  } else if (g < 57) {
    int hd = g - 49; fld = 512; fcol = hd * 64;
    if (!sample) {
      vdst = (u16*)(ws + OFF_VBP) + (size_t)(b * 8 + hd) * 64 * 8192; vS = 8192; vcol0 = trow;
      if (trow >= 7680) { fdst = p.out + O_VBP; frow0 = b * 512 + (trow - 7680); }
    } else { vdst = (u16*)(ws + OFF_VBS) + (size_t)(b * 8 + hd) * 64 * 576; vS = 576; vcol0 = 512; fdst = p.out + O_VBS; frow0 = b * 64; }
  } else if (g < 73) { sig = true; bdst = (u16*)(ws + OFF_GA); brow0 = tbase; bld = 1024; bcol = (g - 57) * 64; }
  else if (g < 89) { sig = true; bdst = (u16*)(ws + OFF_GB); brow0 = tbase; bld = 1024; bcol = (g - 73) * 64; }
  else wi = true;

#pragma unroll
  for (int tn = 0; tn < 2; tn++) {
    const int tl = tn * 32 + r;
    float x[32];
#pragma unroll
    for (int fm = 0; fm < 2; fm++)
#pragma unroll
      for (int i = 0; i < 16; i++) x[fm * 16 + i] = acc[fm][tn][i];
    if (wi) {
      float4 o = make_float4(x[0], x[1], x[2], x[3]);
      *(float4*)((float*)(ws + OFF_WI) + (size_t)(tbase + tl) * 8 + 4 * h) = o;
      continue;
    }
    if (gain) {
      float ss = 0.f;
#pragma unroll
      for (int k = 0; k < 32; k++) ss += x[k] * x[k];
      ss += __shfl_xor(ss, 32);
      float rs = rsqrtf(ss * (1.f / 64.f) + 1e-6f);
#pragma unroll
      for (int fm = 0; fm < 2; fm++)
#pragma unroll
        for (int q4 = 0; q4 < 4; q4++) {
          float4 gg = *(const float4*)(gain + fm * 32 + q4 * 8 + 4 * h);
          x[fm * 16 + q4 * 4 + 0] *= rs * gg.x;
          x[fm * 16 + q4 * 4 + 1] *= rs * gg.y;
          x[fm * 16 + q4 * 4 + 2] *= rs * gg.z;
          x[fm * 16 + q4 * 4 + 3] *= rs * gg.w;
        }
    }
    if (rope) {
      const int pos = sample ? 1024 + tl : trow + tl;
      const float4* cs = (const float4*)((const float2*)(ws + OFF_CS) + (size_t)pos * 8 + 4 * h);
      float4 c01 = cs[0], c23 = cs[1];
      float cc[4] = {c01.x, c01.z, c23.x, c23.z};
      float sn[4] = {c01.y, c01.w, c23.y, c23.w};
#pragma unroll
      for (int i = 0; i < 4; i++) {
        float x1 = x[i], x2 = x[i + 4];
        x[i] = x1 * cc[i] - x2 * sn[i];
        x[i + 4] = x2 * cc[i] + x1 * sn[i];
      }
    }
    if (sig) {
#pragma unroll
      for (int k = 0; k < 32; k++) x[k] = 1.f / (1.f + __expf(-x[k]));
    }
    if (bdst) {
      u16* d = bdst + (brow0 + tl) * (size_t)bld + bcol;
#pragma unroll
      for (int fm = 0; fm < 2; fm++)
#pragma unroll
        for (int q4 = 0; q4 < 4; q4++) {
          uint2 o;
          o.x = pack2(x[fm * 16 + q4 * 4 + 0], x[fm * 16 + q4 * 4 + 1]);
          o.y = pack2(x[fm * 16 + q4 * 4 + 2], x[fm * 16 + q4 * 4 + 3]);
          *(uint2*)(d + fm * 32 + q4 * 8 + 4 * h) = o;
        }
    }
    if (vdst) {
#pragma unroll
      for (int fm = 0; fm < 2; fm++)
#pragma unroll
        for (int i = 0; i < 16; i++) {
          int f = fm * 32 + (i & 3) + 8 * (i >> 2) + 4 * h;
          vdst[(size_t)f * vS + vcol0 + tl] = f2bf(x[fm * 16 + i]);
        }
    }
    if (fdst) {
      float* d = fdst + (frow0 + tl) * (size_t)fld + fcol;
#pragma unroll
      for (int fm = 0; fm < 2; fm++)
#pragma unroll
        for (int q4 = 0; q4 < 4; q4++) {
          float4 o = make_float4(x[fm * 16 + q4 * 4 + 0], x[fm * 16 + q4 * 4 + 1], x[fm * 16 + q4 * 4 + 2], x[fm * 16 + q4 * 4 + 3]);
          *(float4*)(d + fm * 32 + q4 * 8 + 4 * h) = o;
        }
    }
  }
}

__device__ void phase1(const Params& p, unsigned char* smem) {
  GemmSmem& sm = *(GemmSmem*)smem;
  const int tid = threadIdx.x, lane = tid & 63, wave = tid >> 6;
  const u16* W = (const u16*)(p.ws + OFF_WIN);
  const u16* XN = (const u16*)(p.ws + OFF_XN);
  for (int t = blockIdx.x; t < 45 * 130; t += gridDim.x) {
    const int tt = t / 45, ft = t % 45;
    f32x16 acc[2][2];
    zero_acc(acc);
    gemm_kloop<1024>(W + (size_t)ft * 128 * 1024, 1024, XN + (size_t)tt * 256 * 1024, 1024, acc, sm, tid);
    epi_inproj(p, acc, ft * 2 + (wave & 1), tt * 256 + (wave >> 1) * 64, lane);
  }
}

__device__ void phase2(const Params& p, unsigned char* smem) {
  u16 (*sc)[8192] = (u16 (*)[8192])smem;
  unsigned char* ws = p.ws;
  const int tid = threadIdx.x, lane = tid & 63, wave = tid >> 6;
  const int NTILE = 4096 + 64;
  for (int it = blockIdx.x; it < NTILE; it += gridDim.x) {
    const int rr = it >> 8, ww = it & 255;
    const int idx = (rr & 1) ? (rr << 8) + 255 - ww : it;
    int tok0, nvis; const u16* KI; u64* mrow0; int mld;
    if (idx < 4096) {
      int b = idx & 3, j8 = 1023 - (idx >> 2);
      int q0 = j8 * 8;
      tok0 = b * 8192 + q0; nvis = ((q0 >> 6) + 1) * 64;
      KI = (const u16*)(ws + OFF_KIP) + (size_t)b * 8192 * 64;
      mrow0 = (u64*)(ws + OFF_MASKP) + (size_t)tok0 * 128; mld = 128;
    } else {
      int s = idx - 4096; int b = s >> 3, q0 = (s & 7) * 8;
      tok0 = NPROMPT + b * 64 + q0; nvis = 1088;
      KI = (const u16*)(ws + OFF_KIS) + (size_t)b * 1088 * 64;
      mrow0 = (u64*)(ws + OFF_MASKS) + (size_t)(b * 64 + q0) * 32; mld = 32;
    }
    const int nv512 = (nvis + 511) >> 9;
    {
      const int tail = nv512 * 512 - nvis;
      for (int e = tid; e < 8 * tail; e += 512) { int q = e / tail, k = e % tail; sc[q][nvis + k] = 0; }
    }
    const u16* QI = (const u16*)(ws + OFF_QI);
    const float* WI = (const float*)(ws + OFF_WI);
    const int n16 = lane & 15, g4 = lane >> 4;
    bf16x8 qa[4][2]; float4 wv[4];
#pragma unroll
    for (int pp = 0; pp < 4; pp++) {
      const int ql = 2 * pp + (n16 >> 3), hh = n16 & 7;
#pragma unroll
      for (int kh = 0; kh < 2; kh++)
        qa[pp][kh] = as_bf8(*(const uint4*)(QI + (size_t)(tok0 + ql) * 512 + hh * 64 + kh * 32 + 8 * g4));
      wv[pp] = *(const float4*)(WI + (size_t)(tok0 + 2 * pp + (g4 >> 1)) * 8 + 4 * (g4 & 1));
    }
    for (int kg = wave; kg < (nvis >> 4); kg += 8) {
      const u16* kr = KI + (size_t)(kg * 16 + n16) * 64 + 8 * g4;
      bf16x8 k0 = as_bf8(*(const uint4*)(kr));
      bf16x8 k1 = as_bf8(*(const uint4*)(kr + 32));
#pragma unroll
      for (int pp = 0; pp < 4; pp++) {
        f32x4 a = {0.f, 0.f, 0.f, 0.f};
        a = mfma16(qa[pp][0], k0, a);
        a = mfma16(qa[pp][1], k1, a);
        float s = wv[pp].x * fmaxf(a[0], 0.f) + wv[pp].y * fmaxf(a[1], 0.f) + wv[pp].z * fmaxf(a[2], 0.f) + wv[pp].w * fmaxf(a[3], 0.f);
        s += __shfl_xor(s, 16);
        if ((g4 & 1) == 0) {
          _Float16 hv = (_Float16)s;
          u16 bits = __builtin_bit_cast(u16, hv);
          bits ^= (bits & 0x8000) ? (u16)0xFFFF : (u16)0x8000;
          sc[2 * pp + (g4 >> 1)][kg * 16 + n16] = bits;
        }
      }
    }
    __syncthreads();
    {
      const u16* my = sc[wave];
      uint32_t T = 0, need_eq = 0;
      if (nvis > 256) {
        uint32_t lo = 1, hi = 65536;
        while (hi - lo > 1) {
          uint32_t mid = (lo + hi) >> 1;
          uint32_t mh = mid << 16;
          int cnt = 0;
          for (int j = 0; j < nv512; j++) {
            uint4 v = *(const uint4*)(my + (j * 64 + lane) * 8);
            cnt += __popcll(__ballot(v.x >= mh)) + __popcll(__ballot((v.x << 16) >= mh));
            cnt += __popcll(__ballot(v.y >= mh)) + __popcll(__ballot((v.y << 16) >= mh));
            cnt += __popcll(__ballot(v.z >= mh)) + __popcll(__ballot((v.z << 16) >= mh));
            cnt += __popcll(__ballot(v.w >= mh)) + __popcll(__ballot((v.w << 16) >= mh));
          }
          if (cnt >= 256) lo = mid; else hi = mid;
        }
        T = lo;
        int cgt = 0;
        for (int j = 0; j < (nvis >> 6); j++) {
          uint32_t k = my[j * 64 + lane];
          cgt += __popcll(__ballot(k > T));
        }
        need_eq = 256 - cgt;
      }
      u64* mrow = mrow0 + (size_t)wave * mld;
      uint32_t eq_seen = 0;
      u64 myword = 0;
      const int nkb = nvis >> 6;
      for (int kb = 0; kb < nkb; kb++) {
        uint32_t k = my[kb * 64 + lane];
        bool gt = k > T, eq = (k == T);
        u64 beq = __ballot(eq);
        uint32_t rank = __popcll(beq & ((1ull << lane) - 1ull));
        bool sel = gt || (eq && (eq_seen + rank) < need_eq);
        u64 m = __ballot(sel);
        eq_seen += __popcll(beq);
        if (lane == (kb & 63)) myword = m;
        if ((kb & 63) == 63 || kb == nkb - 1) {
          int base = kb & ~63;
          if (base + lane <= kb) mrow[base + lane] = myword;
        }
      }
    }
    __syncthreads();
  }
}

struct AttnSmem { u16 K[64][72]; u16 VT[64][72]; float bias[264]; };

__device__ __forceinline__ void attn_tile(const bool BAND, AttnSmem& sm, u16* Qg, int qtok0, int hd, int nw, const u16* __restrict__ Kg,
                          const u16* __restrict__ VTg, int S, int qloc0, const u64* maskrow0, int mld,
                          const float* bias_tab, int tid) {
  const int lane = tid & 63, wave = tid >> 6;
  const int r = lane & 31, h = lane >> 5;
  const bool wact = wave < nw;
  const int wq0 = qloc0 + 32 * wave;
  const int cw = wq0 >> 6;
  const int c_first = qloc0 >> 6, c_last = (qloc0 + 32 * (nw - 1)) >> 6;
  const int kt_lo = BAND ? (c_first - 8 > 0 ? c_first - 8 : 0) : 0;
  if (BAND) {
    for (int e = tid; e < 257; e += 512) sm.bias[e] = bias_tab[e * 8 + hd] * LOG2E;
  }
  bf16x8 qf[4];
  u16* qrow = Qg + (size_t)(qtok0 + 32 * wave + r) * 512 + hd * 64;
  if (wact) {
#pragma unroll
    for (int kk = 0; kk < 4; kk++) qf[kk] = as_bf8(*(const uint4*)(qrow + kk * 16 + h * 8));
  }
  const u64* mrow = BAND ? nullptr : maskrow0 + (size_t)(32 * wave + r) * mld;
  f32x16 o0, o1;
#pragma unroll
  for (int i = 0; i < 16; i++) { o0[i] = 0.f; o1[i] = 0.f; }
  float lsum = 0.f;
  const float csc = 0.125f * LOG2E;
  const int lrow = tid >> 3, lcol = (tid & 7) * 8;
  for (int kt = kt_lo; kt <= c_last; kt++) {
    __syncthreads();
    {
      uint4 kv = *(const uint4*)(Kg + (size_t)(kt * 64 + lrow) * 64 + lcol);
      uint4 vv = *(const uint4*)(VTg + (size_t)lrow * S + kt * 64 + lcol);
      *(uint4*)&sm.K[lrow][lcol] = kv;
      *(uint4*)&sm.VT[lrow][lcol] = vv;
    }
    __syncthreads();
    const bool act = wact && kt <= cw && (!BAND || kt >= cw - 8);
    if (act) {
      u64 mword = 0;
      if (!BAND) mword = mrow[kt];
#pragma unroll
      for (int sb = 0; sb < 2; sb++) {
        f32x16 s;
#pragma unroll
        for (int i = 0; i < 16; i++) s[i] = 0.f;
#pragma unroll
        for (int kk = 0; kk < 4; kk++) {
          bf16x8 kf = *(const bf16x8*)&sm.K[sb * 32 + r][kk * 16 + h * 8];
          s = mfma32(kf, qf[kk], s);
        }
        float pv[16];
        if (BAND) {
          const int qpos = wq0 + r;
          if (kt <= cw - 3) {
            const float bb = sm.bias[256];
#pragma unroll
            for (int i = 0; i < 16; i++) pv[i] = exp2f(s[i] * csc + bb);
          } else {
#pragma unroll
            for (int i = 0; i < 16; i++) {
              int kpos = kt * 64 + sb * 32 + (i & 3) + 8 * (i >> 2) + 4 * h;
              int dd = qpos - kpos;
              dd = dd < -128 ? -128 : (dd > 128 ? 128 : dd);
              pv[i] = exp2f(s[i] * csc + sm.bias[dd + 128]);
            }
          }
        } else {
          const uint32_t mw = (uint32_t)(mword >> (sb * 32)) >> (4 * h);
#pragma unroll
          for (int i = 0; i < 16; i++) {
            const int bit = (i & 3) + 8 * (i >> 2);
            float e = exp2f(s[i] * csc);
            pv[i] = ((mw >> bit) & 1u) ? e : 0.f;
          }
        }
#pragma unroll
        for (int i = 0; i < 16; i++) lsum += pv[i];
#pragma unroll
        for (int st = 0; st < 2; st++) {
          union { uint32_t u[4]; bf16x8 b; } pf;
#pragma unroll
          for (int j = 0; j < 4; j++) pf.u[j] = pack2(pv[8 * st + 2 * j], pv[8 * st + 2 * j + 1]);
          union { uint2 u[2]; bf16x8 b; } v0, v1;
          const int kc = sb * 32 + 16 * st + 4 * h;
          v0.u[0] = *(const uint2*)&sm.VT[r][kc];
          v0.u[1] = *(const uint2*)&sm.VT[r][kc + 8];
          v1.u[0] = *(const uint2*)&sm.VT[32 + r][kc];
          v1.u[1] = *(const uint2*)&sm.VT[32 + r][kc + 8];
          o0 = mfma32(v0.b, pf.b, o0);
          o1 = mfma32(v1.b, pf.b, o1);
        }
      }
    }
  }
  if (wact) {
    lsum += __shfl_xor(lsum, 32);
    const float inv = 1.f / lsum;
#pragma unroll
    for (int q4 = 0; q4 < 4; q4++) {
      uint2 a, b;
      a.x = pack2(o0[q4 * 4 + 0] * inv, o0[q4 * 4 + 1] * inv);
      a.y = pack2(o0[q4 * 4 + 2] * inv, o0[q4 * 4 + 3] * inv);
      b.x = pack2(o1[q4 * 4 + 0] * inv, o1[q4 * 4 + 1] * inv);
      b.y = pack2(o1[q4 * 4 + 2] * inv, o1[q4 * 4 + 3] * inv);
      *(uint2*)(qrow + q4 * 8 + 4 * h) = a;
      *(uint2*)(qrow + 32 + q4 * 8 + 4 * h) = b;
    }
  }
  __syncthreads();
}

__device__ void phase3(const Params& p, unsigned char* smem) {
  AttnSmem& sm = *(AttnSmem*)smem;
  unsigned char* ws = p.ws;
  const int tid = threadIdx.x;
  const int NITEM = 1024 + 1024 + 64 + 64;
  for (int it = blockIdx.x; it < NITEM; it += gridDim.x) {
    bool band; int qtok0, hd, nw, S, qloc0, mld = 0; u16* Qg; const u16* Kg; const u16* VTg; const u64* mrow0 = nullptr;
    if (it < 1024) {
      const int rr = it >> 8, ww = it & 255;
      const int w2 = (rr & 1) ? 255 - ww : ww;
      const int j = 31 - (rr * 8 + (w2 >> 5)), bh = w2 & 31;
      const int b = bh >> 3; hd = bh & 7;
      band = false; Qg = (u16*)(ws + OFF_QA); qtok0 = b * 8192 + j * 256; nw = 8; S = 8192; qloc0 = j * 256;
      Kg = (const u16*)(ws + OFF_KAP) + (size_t)(b * 8 + hd) * 8192 * 64;
      VTg = (const u16*)(ws + OFF_VAP) + (size_t)(b * 8 + hd) * 64 * 8192;
      mrow0 = (const u64*)(ws + OFF_MASKP) + (size_t)(b * 8192 + j * 256) * 128; mld = 128;
    } else if (it < 2048) {
      const int u = it - 1024;
      const int j = u >> 5, bh = u & 31;
      const int b = bh >> 3; hd = bh & 7;
      band = true; Qg = (u16*)(ws + OFF_QB); qtok0 = b * 8192 + j * 256; nw = 8; S = 8192; qloc0 = j * 256;
      Kg = (const u16*)(ws + OFF_KBP) + (size_t)(b * 8 + hd) * 8192 * 64;
      VTg = (const u16*)(ws + OFF_VBP) + (size_t)(b * 8 + hd) * 64 * 8192;
    } else if (it < 2048 + 64) {
      const int u = it - 2048;
      const int b = u >> 3; hd = u & 7;
      band = false; Qg = (u16*)(ws + OFF_QA); qtok0 = NPROMPT + b * 64; nw = 2; S = 1088; qloc0 = 1024;
      Kg = (const u16*)(ws + OFF_KAS) + (size_t)(b * 8 + hd) * 1088 * 64;
      VTg = (const u16*)(ws + OFF_VAS) + (size_t)(b * 8 + hd) * 64 * 1088;
      mrow0 = (const u64*)(ws + OFF_MASKS) + (size_t)(b * 64) * 32; mld = 32;
    } else {
      const int u = it - 2048 - 64;
      const int b = u >> 3; hd = u & 7;
      band = true; Qg = (u16*)(ws + OFF_QB); qtok0 = NPROMPT + b * 64; nw = 2; S = 576; qloc0 = 512;
      Kg = (const u16*)(ws + OFF_KBS) + (size_t)(b * 8 + hd) * 576 * 64;
      VTg = (const u16*)(ws + OFF_VBS) + (size_t)(b * 8 + hd) * 64 * 576;
    }
    attn_tile(band, sm, Qg, qtok0, hd, nw, Kg, VTg, S, qloc0, mrow0, mld, p.in[14], tid);
  }
}

__device__ void phase4(const Params& p, unsigned char* smem) {
  GemmSmem& sm = *(GemmSmem*)smem;
  unsigned char* ws = p.ws;
  const int tid = threadIdx.x, lane = tid & 63, wave = tid >> 6;
  const int r = lane & 31, h = lane >> 5;
  for (int t = blockIdx.x; t < 8 * 130; t += gridDim.x) {
    const int tt = t >> 3, ft = t & 7;
    const int fbase = ft * 128 + (wave & 1) * 64, tbase = tt * 256 + (wave >> 1) * 64;
    const u16* GA = (const u16*)(ws + OFF_GA); const u16* GB = (const u16*)(ws + OFF_GB);
    u16* M = (u16*)(ws + OFF_M);
    {
      f32x16 a1[2][2];
      zero_acc(a1);
      gemm_kloop<512>((const u16*)(ws + OFF_WOA) + (size_t)ft * 128 * 512, 512, (const u16*)(ws + OFF_QA) + (size_t)tt * 256 * 512, 512, a1, sm, tid);
#pragma unroll
      for (int tn = 0; tn < 2; tn++) {
        const size_t token = tbase + tn * 32 + r;
#pragma unroll
        for (int fm = 0; fm < 2; fm++)
#pragma unroll
          for (int q4 = 0; q4 < 4; q4++) {
            const int f = fbase + fm * 32 + q4 * 8 + 4 * h;
            uint2 ga = *(const uint2*)(GA + token * 1024 + f);
            uint2 o;
            o.x = pack2(bflo(ga.x) * a1[fm][tn][q4 * 4 + 0], bfhi(ga.x) * a1[fm][tn][q4 * 4 + 1]);
            o.y = pack2(bflo(ga.y) * a1[fm][tn][q4 * 4 + 2], bfhi(ga.y) * a1[fm][tn][q4 * 4 + 3]);
            *(uint2*)(M + token * 1024 + f) = o;
          }
      }
    }
    {
      f32x16 a2[2][2];
      zero_acc(a2);
      gemm_kloop<512>((const u16*)(ws + OFF_WOB) + (size_t)ft * 128 * 512, 512, (const u16*)(ws + OFF_QB) + (size_t)tt * 256 * 512, 512, a2, sm, tid);
#pragma unroll
      for (int tn = 0; tn < 2; tn++) {
        const size_t token = tbase + tn * 32 + r;
#pragma unroll
        for (int fm = 0; fm < 2; fm++)
#pragma unroll
          for (int q4 = 0; q4 < 4; q4++) {
            const int f = fbase + fm * 32 + q4 * 8 + 4 * h;
            uint2 gb = *(const uint2*)(GB + token * 1024 + f);
            uint2 mo = *(const uint2*)(M + token * 1024 + f);
            float m0 = bflo(mo.x) + bflo(gb.x) * a2[fm][tn][q4 * 4 + 0];
            float mm1 = bfhi(mo.x) + bfhi(gb.x) * a2[fm][tn][q4 * 4 + 1];
            float m2 = bflo(mo.y) + bflo(gb.y) * a2[fm][tn][q4 * 4 + 2];
            float m3 = bfhi(mo.y) + bfhi(gb.y) * a2[fm][tn][q4 * 4 + 3];
            uint2 o; o.x = pack2(m0, mm1); o.y = pack2(m2, m3);
            *(uint2*)(M + token * 1024 + f) = o;
          }
      }
    }
  }
}

__device__ void phase5(const Params& p, unsigned char* smem) {
  GemmSmem& sm = *(GemmSmem*)smem;
  unsigned char* ws = p.ws;
  const int tid = threadIdx.x, lane = tid & 63, wave = tid >> 6;
  const int r = lane & 31, h = lane >> 5;
  for (int t = blockIdx.x; t < 8 * 130; t += gridDim.x) {
    const int tt = t >> 3, ft = t & 7;
    f32x16 acc[2][2];
    zero_acc(acc);
    gemm_kloop<1024>((const u16*)(ws + OFF_WOUT) + (size_t)ft * 128 * 1024, 1024, (const u16*)(ws + OFF_M) + (size_t)tt * 256 * 1024, 1024, acc, sm, tid);
    const int fbase = ft * 128 + (wave & 1) * 64, tbase = tt * 256 + (wave >> 1) * 64;
    u16* X1B = (u16*)(ws + OFF_X1B);
    float* rss = (float*)(ws + OFF_ROWSS);
#pragma unroll
    for (int tn = 0; tn < 2; tn++) {
      const int token = tbase + tn * 32 + r;
      const float* xr = xrow(p, token);
      float ss = 0.f;
#pragma unroll
      for (int fm = 0; fm < 2; fm++)
#pragma unroll
        for (int q4 = 0; q4 < 4; q4++) {
          const int f = fbase + fm * 32 + q4 * 8 + 4 * h;
          float4 xv = *(const float4*)(xr + f);
          float4 o = make_float4(xv.x + acc[fm][tn][q4 * 4 + 0], xv.y + acc[fm][tn][q4 * 4 + 1], xv.z + acc[fm][tn][q4 * 4 + 2], xv.w + acc[fm][tn][q4 * 4 + 3]);
          ss += o.x * o.x + o.y * o.y + o.z * o.z + o.w * o.w;
          *(float4*)(p.out + O_Y + (size_t)token * 1024 + f) = o;
          uint2 ob; ob.x = pack2(o.x, o.y); ob.y = pack2(o.z, o.w);
          *(uint2*)(X1B + (size_t)token * 1024 + f) = ob;
        }
      ss += __shfl_xor(ss, 32);
      if (h == 0) atomicAdd(rss + token, ss);
    }
  }
}

__device__ void phase6(const Params& p, unsigned char* smem) {
  GemmSmem& sm = *(GemmSmem*)smem;
  unsigned char* ws = p.ws;
  const int tid = threadIdx.x, lane = tid & 63, wave = tid >> 6;
  const int r = lane & 31, h = lane >> 5;
  for (int t = blockIdx.x; t < 32 * 130; t += gridDim.x) {
    const int tt = t >> 5, ft = t & 31;
    f32x16 acc[2][2];
    zero_acc(acc);
    gemm_kloop<1024>((const u16*)(ws + OFF_WUP) + (size_t)ft * 128 * 1024, 1024, (const u16*)(ws + OFF_X1B) + (size_t)tt * 256 * 1024, 1024, acc, sm, tid);
    const int fbase = ft * 128 + (wave & 1) * 64, tbase = tt * 256 + (wave >> 1) * 64;
    u16* H = (u16*)(ws + OFF_H);
    const float* rss = (const float*)(ws + OFF_ROWSS);
#pragma unroll
    for (int tn = 0; tn < 2; tn++) {
      const size_t token = tbase + tn * 32 + r;
      const float rs = rsqrtf(rss[token] * (1.f / 1024.f) + 1e-6f);
#pragma unroll
      for (int fm = 0; fm < 2; fm++)
#pragma unroll
        for (int q4 = 0; q4 < 4; q4++) {
          const int f = fbase + fm * 32 + q4 * 8 + 4 * h;
          float v0 = fmaxf(acc[fm][tn][q4 * 4 + 0] * rs, 0.f), v1 = fmaxf(acc[fm][tn][q4 * 4 + 1] * rs, 0.f);
          float v2 = fmaxf(acc[fm][tn][q4 * 4 + 2] * rs, 0.f), v3 = fmaxf(acc[fm][tn][q4 * 4 + 3] * rs, 0.f);
          uint2 o; o.x = pack2(v0 * v0, v1 * v1); o.y = pack2(v2 * v2, v3 * v3);
          *(uint2*)(H + token * 4096 + f) = o;
        }
    }
  }
}

__device__ void phase7(const Params& p, unsigned char* smem) {
  GemmSmem& sm = *(GemmSmem*)smem;
  unsigned char* ws = p.ws;
  const int tid = threadIdx.x, lane = tid & 63, wave = tid >> 6;
  const int r = lane & 31, h = lane >> 5;
  for (int t = blockIdx.x; t < 8 * 130; t += gridDim.x) {
    const int tt = t >> 3, ft = t & 7;
    f32x16 acc[2][2];
    zero_acc(acc);
    gemm_kloop<4096>((const u16*)(ws + OFF_WDN) + (size_t)ft * 128 * 4096, 4096, (const u16*)(ws + OFF_H) + (size_t)tt * 256 * 4096, 4096, acc, sm, tid);
    const int fbase = ft * 128 + (wave & 1) * 64, tbase = tt * 256 + (wave >> 1) * 64;
#pragma unroll
    for (int tn = 0; tn < 2; tn++) {
      const size_t token = tbase + tn * 32 + r;
#pragma unroll
      for (int fm = 0; fm < 2; fm++)
#pragma unroll
        for (int q4 = 0; q4 < 4; q4++) {
          const int f = fbase + fm * 32 + q4 * 8 + 4 * h;
          float* yp = p.out + O_Y + token * 1024 + f;
          float4 y = *(const float4*)yp;
          y.x += acc[fm][tn][q4 * 4 + 0]; y.y += acc[fm][tn][q4 * 4 + 1]; y.z += acc[fm][tn][q4 * 4 + 2]; y.w += acc[fm][tn][q4 * 4 + 3];
          *(float4*)yp = y;
        }
    }
  }
}

__global__ void __launch_bounds__(512) mega(Params p, int ph_lo, int ph_hi) {
  __shared__ __align__(16) unsigned char smem[SMEM_BYTES];
#define RUN_PHASE(k, fn)                                  \
  if (ph_lo <= k && k <= ph_hi) {                         \
    fn(p, smem);                                          \
    if (k < ph_hi) cg::this_grid().sync();                \
  }
  RUN_PHASE(0, phase0)
  RUN_PHASE(1, phase1)
  RUN_PHASE(2, phase2)
  RUN_PHASE(3, phase3)
  RUN_PHASE(4, phase4)
  RUN_PHASE(5, phase5)
  RUN_PHASE(6, phase6)
  RUN_PHASE(7, phase7)
}

extern "C" void kernel_launch(void* const* d_in, const int* in_sizes, int n_in, void* d_out, int out_size,
                              void* d_ws, size_t ws_size, hipStream_t stream) {
  Params p{};
  for (int i = 0; i < 21; i++) p.in[i] = (const float*)d_in[i];
  p.out = (float*)d_out;
  p.ws = (unsigned char*)d_ws;
  static int grid_blocks = 0;
  if (!grid_blocks) {
    int dev = 0, cus = 0, per_cu = 0;
    hipGetDevice(&dev);
    hipDeviceGetAttribute(&cus, hipDeviceAttributeMultiprocessorCount, dev);
    hipOccupancyMaxActiveBlocksPerMultiprocessor(&per_cu, mega, 512, 0);
    if (per_cu < 1) per_cu = 1;
    grid_blocks = cus * per_cu;
  }
#if MULTI_LAUNCH
  for (int ph = 0; ph < 8; ph++) {
    hipLaunchKernelGGL(mega, dim3(grid_blocks), dim3(512), 0, stream, p, ph, ph);
  }
#else
  int lo = 0, hi = 7;
  void* args[] = {&p, &lo, &hi};
  hipError_t e = hipLaunchCooperativeKernel((void*)mega, dim3(grid_blocks), dim3(512), args, 0, stream);
  if (e != hipSuccess) fprintf(stderr, "cooperative launch failed: %s (grid %d)\n", hipGetErrorString(e), grid_blocks);
#endif
}
```

```cpp
#include <hip/hip_runtime.h>
#include <hip/hip_cooperative_groups.h>
#include <stdint.h>
#include <cstdio>
namespace cg = cooperative_groups;

typedef __attribute__((ext_vector_type(8))) short bf16x8;
typedef __attribute__((ext_vector_type(16))) float f32x16;
typedef __attribute__((ext_vector_type(4))) float f32x4;
typedef unsigned short u16;
typedef unsigned long long u64;

#ifndef PROBE_KLOOP
#define PROBE_KLOOP 0
#endif
#ifndef PROBE_REP2
#define PROBE_REP2 0
#endif
#ifndef PROBE_DRY3
#define PROBE_DRY3 0
#endif
#ifndef MULTI_LAUNCH
#define MULTI_LAUNCH 0
#endif

#define NTOK 33280
#define NPROMPT 32768
#define DM 1024
#define DFF 4096
#define NIN 5888
#define LOG2E 1.4426950408889634f

constexpr size_t AL(size_t x) { return (x + 255) & ~(size_t)255; }
constexpr size_t OFF_WIN = 0;
constexpr size_t OFF_WOA = OFF_WIN + AL((size_t)NIN * 1024 * 2);
constexpr size_t OFF_WOB = OFF_WOA + AL((size_t)1024 * 512 * 2);
constexpr size_t OFF_WOUT = OFF_WOB + AL((size_t)1024 * 512 * 2);
constexpr size_t OFF_WUP = OFF_WOUT + AL((size_t)1024 * 1024 * 2);
constexpr size_t OFF_WDN = OFF_WUP + AL((size_t)4096 * 1024 * 2);
constexpr size_t OFF_CS = OFF_WDN + AL((size_t)4096 * 1024 * 2);
constexpr size_t OFF_ROWSS = OFF_CS + AL((size_t)8192 * 8 * 8);
constexpr size_t OFF_XN = OFF_ROWSS + AL((size_t)NTOK * 4);
constexpr size_t OFF_MASKP = OFF_XN;
constexpr size_t OFF_MASKS = OFF_MASKP + (size_t)NPROMPT * 128 * 8;
constexpr size_t OFF_X1B = OFF_XN;
constexpr size_t OFF_Z = OFF_XN + AL((size_t)NTOK * 1024 * 2);
constexpr size_t OFF_QA = OFF_Z;
constexpr size_t OFF_QB = OFF_QA + AL((size_t)NTOK * 512 * 2);
constexpr size_t OFF_QI = OFF_QB + AL((size_t)NTOK * 512 * 2);
constexpr size_t OFF_GA = OFF_QI + AL((size_t)NTOK * 512 * 2);
constexpr size_t OFF_GB = OFF_GA + AL((size_t)NTOK * 1024 * 2);
constexpr size_t OFF_WI = OFF_GB + AL((size_t)NTOK * 1024 * 2);
constexpr size_t OFF_KAP = OFF_WI + AL((size_t)NTOK * 8 * 4);
constexpr size_t OFF_KAS = OFF_KAP + AL((size_t)4 * 8 * 8192 * 64 * 2);
constexpr size_t OFF_VAP = OFF_KAS + AL((size_t)8 * 8 * 1088 * 64 * 2);
constexpr size_t OFF_VAS = OFF_VAP + AL((size_t)4 * 8 * 8192 * 64 * 2);
constexpr size_t OFF_KIP = OFF_VAS + AL((size_t)8 * 8 * 1088 * 64 * 2);
constexpr size_t OFF_KIS = OFF_KIP + AL((size_t)4 * 8192 * 64 * 2);
constexpr size_t OFF_KBP = OFF_KIS + AL((size_t)8 * 1088 * 64 * 2);
constexpr size_t OFF_KBS = OFF_KBP + AL((size_t)4 * 8 * 8192 * 64 * 2);
constexpr size_t OFF_VBP = OFF_KBS + AL((size_t)8 * 8 * 576 * 64 * 2);
constexpr size_t OFF_VBS = OFF_VBP + AL((size_t)4 * 8 * 8192 * 64 * 2);
constexpr size_t OFF_END = OFF_VBS + AL((size_t)8 * 8 * 576 * 64 * 2);
constexpr size_t OFF_M = OFF_KAP;
constexpr size_t OFF_H = OFF_Z;
static_assert(OFF_MASKS + (size_t)512 * 32 * 8 <= OFF_Z, "mask overlay");
static_assert(OFF_M + (size_t)NTOK * 1024 * 2 <= OFF_END, "M overlay");
static_assert(OFF_H + (size_t)NTOK * 4096 * 2 <= OFF_END, "H overlay");
static_assert(OFF_END <= (size_t)512 * 1024 * 1024, "ws budget");

constexpr size_t O_Y = 0;
constexpr size_t O_KAP = (size_t)NTOK * 1024;
constexpr size_t O_VAP = O_KAP + (size_t)4 * 8192 * 512;
constexpr size_t O_KIP = O_VAP + (size_t)4 * 8192 * 512;
constexpr size_t O_KBP = O_KIP + (size_t)4 * 8192 * 64;
constexpr size_t O_VBP = O_KBP + (size_t)4 * 512 * 512;
constexpr size_t O_KAS = O_VBP + (size_t)4 * 512 * 512;
constexpr size_t O_VAS = O_KAS + (size_t)8 * 64 * 512;
constexpr size_t O_KIS = O_VAS + (size_t)8 * 64 * 512;
constexpr size_t O_KBS = O_KIS + (size_t)8 * 64 * 64;
constexpr size_t O_VBS = O_KBS + (size_t)8 * 64 * 512;

struct Params {
  const float* in[21];
  float* out;
  unsigned char* ws;
};

__device__ __forceinline__ u16 f2bf(float f) {
  uint32_t u = __float_as_uint(f);
  u += 0x7FFFu + ((u >> 16) & 1u);
  return (u16)(u >> 16);
}
typedef __bf16 bf16v2 __attribute__((ext_vector_type(2)));
typedef float f32v2 __attribute__((ext_vector_type(2)));
__device__ __forceinline__ uint32_t pack2(float a, float b) {
  f32v2 v = {a, b};
  bf16v2 r = __builtin_convertvector(v, bf16v2);
  return __builtin_bit_cast(uint32_t, r);
}
__device__ __forceinline__ float bf2f(u16 v) { return __uint_as_float(((uint32_t)v) << 16); }
__device__ __forceinline__ float bflo(uint32_t v) { return __uint_as_float(v << 16); }
__device__ __forceinline__ float bfhi(uint32_t v) { return __uint_as_float(v & 0xFFFF0000u); }
__device__ __forceinline__ f32x16 mfma32(bf16x8 a, bf16x8 b, f32x16 c) {
  return __builtin_amdgcn_mfma_f32_32x32x16_bf16(a, b, c, 0, 0, 0);
}
__device__ __forceinline__ f32x4 mfma16(bf16x8 a, bf16x8 b, f32x4 c) {
  return __builtin_amdgcn_mfma_f32_16x16x32_bf16(a, b, c, 0, 0, 0);
}
__device__ __forceinline__ bf16x8 as_bf8(uint4 v) {
  union { uint4 u; bf16x8 b; } x; x.u = v; return x.b;
}
__device__ __forceinline__ const float* xrow(const Params& p, int token) {
  return token < NPROMPT ? p.in[0] + (size_t)token * 1024 : p.in[1] + (size_t)(token - NPROMPT) * 1024;
}

__device__ __forceinline__ float xsum16(float v) {
  auto r = __builtin_amdgcn_permlane16_swap(__float_as_uint(v), __float_as_uint(v), false, false);
  return __uint_as_float(r[0]) + __uint_as_float(r[1]);
}
__device__ __forceinline__ float xsum32(float v) {
  auto r = __builtin_amdgcn_permlane32_swap(__float_as_uint(v), __float_as_uint(v), false, false);
  return __uint_as_float(r[0]) + __uint_as_float(r[1]);
}
__device__ __forceinline__ float xother32(float v, bool lower_half) {
  auto r = __builtin_amdgcn_permlane32_swap(__float_as_uint(v), __float_as_uint(v), false, false);
  return lower_half ? __uint_as_float(r[1]) : __uint_as_float(r[0]);
}

#define SMEM_BYTES (131072 + 8192)

struct GemmSmem { u16 A[2][128][72]; u16 B[2][256][72]; };

#define GEMM_MMA(cb, kk)                                                               \
  {                                                                                    \
    bf16x8 a0_ = *(const bf16x8*)&sm.A[cb][wf * 64 + r][(kk) * 16 + h * 8];            \
    bf16x8 a1_ = *(const bf16x8*)&sm.A[cb][wf * 64 + 32 + r][(kk) * 16 + h * 8];       \
    bf16x8 b0_ = *(const bf16x8*)&sm.B[cb][wt * 64 + r][(kk) * 16 + h * 8];            \
    bf16x8 b1_ = *(const bf16x8*)&sm.B[cb][wt * 64 + 32 + r][(kk) * 16 + h * 8];       \
    acc[0][0] = mfma32(a0_, b0_, acc[0][0]);                                           \
    acc[0][1] = mfma32(a0_, b1_, acc[0][1]);                                           \
    acc[1][0] = mfma32(a1_, b0_, acc[1][0]);                                           \
    acc[1][1] = mfma32(a1_, b1_, acc[1][1]);                                           \
  }
#define GEMM_STEP(cb, A0, A1, B0, B1, B2, B3, dowrite, doload, tload)                  \
  {                                                                                    \
    GEMM_MMA(cb, 0)                                                                    \
    if (dowrite) { *(uint4*)&sm.A[cb ^ 1][crow][ccol] = A0; *(uint4*)&sm.A[cb ^ 1][crow + 64][ccol] = A1; } \
    __builtin_amdgcn_sched_barrier(0);                                                 \
    GEMM_MMA(cb, 1)                                                                    \
    if (dowrite) { *(uint4*)&sm.B[cb ^ 1][crow][ccol] = B0; *(uint4*)&sm.B[cb ^ 1][crow + 64][ccol] = B1; } \
    __builtin_amdgcn_sched_barrier(0);                                                 \
    GEMM_MMA(cb, 2)                                                                    \
    if (dowrite) { *(uint4*)&sm.B[cb ^ 1][crow + 128][ccol] = B2; *(uint4*)&sm.B[cb ^ 1][crow + 192][ccol] = B3; } \
    __builtin_amdgcn_sched_barrier(0);                                                 \
    GEMM_MMA(cb, 3)                                                                    \
    if (doload) {                                                                      \
      const u16* ap_ = ap + (size_t)(tload) * 64; const u16* bp_ = bp + (size_t)(tload) * 64; \
      A0 = *(const uint4*)(ap_); A1 = *(const uint4*)(ap_ + as64);                     \
      B0 = *(const uint4*)(bp_); B1 = *(const uint4*)(bp_ + bs64); B2 = *(const uint4*)(bp_ + 2 * bs64); B3 = *(const uint4*)(bp_ + 3 * bs64); \
    }                                                                                  \
    __syncthreads();                                                                   \
  }

template <int KTOT>
__device__ __forceinline__ void gemm_kloop(const u16* __restrict__ Ag, int lda, const u16* __restrict__ Bg, int ldb,
                                           f32x16 (&acc)[2][2], GemmSmem& sm, int tid) {
  const int lane = tid & 63, wave = tid >> 6;
  const int wf = wave & 1, wt = wave >> 1;
  const int r = lane & 31, h = lane >> 5;
  constexpr int KT = KTOT / 64;
  const int crow = tid >> 3, ccol = (tid & 7) * 8;
  const u16* ap = Ag + (size_t)crow * lda + ccol;
  const u16* bp = Bg + (size_t)crow * ldb + ccol;
  const size_t as64 = (size_t)64 * lda, bs64 = (size_t)64 * ldb;
  uint4 ra0 = *(const uint4*)(ap), ra1 = *(const uint4*)(ap + as64);
  uint4 rb0 = *(const uint4*)(bp), rb1 = *(const uint4*)(bp + bs64), rb2 = *(const uint4*)(bp + 2 * bs64), rb3 = *(const uint4*)(bp + 3 * bs64);
  *(uint4*)&sm.A[0][crow][ccol] = ra0;
  *(uint4*)&sm.A[0][crow + 64][ccol] = ra1;
  *(uint4*)&sm.B[0][crow][ccol] = rb0;
  *(uint4*)&sm.B[0][crow + 64][ccol] = rb1;
  *(uint4*)&sm.B[0][crow + 128][ccol] = rb2;
  *(uint4*)&sm.B[0][crow + 192][ccol] = rb3;
  ra0 = *(const uint4*)(ap + 64); ra1 = *(const uint4*)(ap + 64 + as64);
  rb0 = *(const uint4*)(bp + 64); rb1 = *(const uint4*)(bp + 64 + bs64); rb2 = *(const uint4*)(bp + 64 + 2 * bs64); rb3 = *(const uint4*)(bp + 64 + 3 * bs64);
  __syncthreads();
  for (int kt = 0; kt < KT; kt += 2) {
    GEMM_STEP(0, ra0, ra1, rb0, rb1, rb2, rb3, true, (kt + 2 < KT), kt + 2)
    GEMM_STEP(1, ra0, ra1, rb0, rb1, rb2, rb3, (kt + 2 < KT), (kt + 3 < KT), kt + 3)
  }
}

__device__ __forceinline__ void tile_range(int N, int& lo, int& hi, int& step) {
  if ((gridDim.x & 7) == 0) {
    const int x = blockIdx.x & 7, l = blockIdx.x >> 3;
    lo = (int)((long long)x * N / 8) + l; hi = (int)((long long)(x + 1) * N / 8); step = gridDim.x >> 3;
  } else { lo = blockIdx.x; hi = N; step = gridDim.x; }
}
__device__ __forceinline__ void tile_decode(int i, int NF, int& ft, int& tt) {
  const int full = 128 * NF;
  if (i < full) { const int g = i / (4 * NF); const int rem = i - g * 4 * NF; ft = rem >> 2; tt = 4 * g + (rem & 3); }
  else { const int rem = i - full; ft = rem >> 1; tt = 128 + (rem & 1); }
}

__device__ __forceinline__ void zero_acc(f32x16 (&acc)[2][2]) {
#pragma unroll
  for (int a = 0; a < 2; a++)
#pragma unroll
    for (int b = 0; b < 2; b++)
#pragma unroll
      for (int i = 0; i < 16; i++) acc[a][b][i] = 0.f;
}

namespace pg8 {
#define PG8_LAS __attribute__((address_space(3)))
constexpr int BM = 256, BK = 64, HALF = 128, HTB = HALF * BK * 2, STAGE_BYTES = 8 * HTB;
__device__ __forceinline__ int lds_byte(int r, int c) { const int st = (r >> 4) * 2 + (c >> 5), rr = r & 15, cc = c & 31, ob = rr * 64 + cc * 2; return st * 1024 + (ob ^ (((ob >> 9) & 1) << 5)); }
__device__ __forceinline__ void stage_rc(int b, int& R, int& C) { const int st = b / 1024, sb = b % 1024, swz = sb ^ (((sb >> 9) & 1) << 5); R = (st >> 1) * 16 + swz / 64; C = (st & 1) * 32 + (swz % 64) / 2; }
struct Unit { int pm, pn; };
struct Gemm { const u16* A; const u16* Bt; int K; };

template <class Epi, class Sched>
__device__ __forceinline__ void gemm_phase(PG8_LAS unsigned char* lds, const Gemm g, const Sched& S, const Epi& E) {
    const int tid = threadIdx.x, wid = __builtin_amdgcn_readfirstlane(tid >> 6), lane = tid & 63, wr = wid >> 2, wc = wid & 3, fr = lane & 15, fq = lane >> 4;
    const int K = g.K, nt = K / BK;
    unsigned voffA[2], voffB[2];
#pragma unroll
    for (int i = 0; i < 2; ++i) { int R, C; stage_rc(tid * 16 + i * 8192, R, C); voffA[i] = (unsigned)(R * K + C) * 2u; voffB[i] = voffA[i]; }
    const size_t kstep = (size_t)(BK * 2);
    const size_t hstep = (size_t)HALF * K * 2;
    const size_t tstep = 2 * hstep;
    const unsigned ldsw = (unsigned)wid * 1024u;
    const int aoff = lds_byte(wr * 64 + fr, fq * 8), boff = lds_byte(wc * 32 + fr, fq * 8);
#define PG8_SA(b, h) (((b) * 2 + (h)) * HTB)
#define PG8_SB(b, h) ((4 + (b) * 2 + (h)) * HTB)
#define PG8_STAGE(bufoff, gbase, voff) do { _Pragma("unroll") for (int _i = 0; _i < 2; ++_i) \
        __builtin_amdgcn_global_load_lds((const unsigned*)((const char*)(gbase) + (voff)[_i]), (PG8_LAS unsigned*)(lds + (bufoff) + ldsw + _i * 8192), 16, 0, 0); } while (0)
#define PG8_LDA(dst, b, h) do { _Pragma("unroll") for (int m = 0; m < 4; ++m) _Pragma("unroll") for (int k = 0; k < 2; ++k) dst[m][k] = *(const PG8_LAS bf16x8*)(lds + PG8_SA(b, h) + aoff + m * 2048 + k * 1024); } while (0)
#define PG8_LDB(dst, b, h) do { _Pragma("unroll") for (int n = 0; n < 2; ++n) _Pragma("unroll") for (int k = 0; k < 2; ++k) dst[n][k] = *(const PG8_LAS bf16x8*)(lds + PG8_SB(b, h) + boff + n * 2048 + k * 1024); } while (0)
#define PG8_MMA(ai, bj, At, Bt) do { __builtin_amdgcn_s_setprio(1); _Pragma("unroll") for (int m = 0; m < 4; ++m) _Pragma("unroll") for (int n = 0; n < 2; ++n) _Pragma("unroll") for (int k = 0; k < 2; ++k) \
        acc[ai][bj][m][n] = __builtin_amdgcn_mfma_f32_16x16x32_bf16(Bt[n][k], At[m][k], acc[ai][bj][m][n], 0, 0, 0); __builtin_amdgcn_s_setprio(0); } while (0)
#define PG8_WAIT_V(n) asm volatile("s_waitcnt vmcnt(" #n ")" ::: "memory")
#define PG8_WAIT_L(n) asm volatile("s_waitcnt lgkmcnt(" #n ")" ::: "memory")
#define PG8_BAR __builtin_amdgcn_s_barrier()
#define PG8_SCHED __builtin_amdgcn_sched_barrier(0)
    Unit cur, nxt; int ui = 0;
    if (!S.next(0, cur)) return;
    f32x4 acc[2][2][4][2];
#pragma unroll
    for (int a = 0; a < 2; ++a)
#pragma unroll
        for (int b = 0; b < 2; ++b)
#pragma unroll
            for (int m = 0; m < 4; ++m)
#pragma unroll
                for (int n = 0; n < 2; ++n) acc[a][b][m][n] = (f32x4){0.f, 0.f, 0.f, 0.f};
    bf16x8 At[4][2], B0[2][2], B1[2][2];
    const char* cA = (const char*)g.A + (size_t)cur.pm * tstep; const char* cB = (const char*)g.Bt + (size_t)cur.pn * tstep;
    PG8_STAGE(PG8_SB(0, 0), cB, voffB); PG8_STAGE(PG8_SA(0, 0), cA, voffA); PG8_STAGE(PG8_SB(0, 1), cB + hstep, voffB); PG8_STAGE(PG8_SA(0, 1), cA + hstep, voffA);
    if (wr == 1) PG8_BAR;
    PG8_WAIT_V(4); PG8_BAR;
    PG8_STAGE(PG8_SB(1, 0), cB + kstep, voffB); PG8_STAGE(PG8_SA(1, 0), cA + kstep, voffA); PG8_STAGE(PG8_SB(1, 1), cB + hstep + kstep, voffB);
    PG8_WAIT_V(6); PG8_BAR;
    for (;;) {
        const bool has_next = S.next(ui + 1, nxt);
        const char* nA = has_next ? (const char*)g.A + (size_t)nxt.pm * tstep : cA; const char* nB = has_next ? (const char*)g.Bt + (size_t)nxt.pn * tstep : cB;
        for (int t = 0; t < nt; t += 2) {
            const bool last = (t == nt - 2);
            const char* a1 = cA + (size_t)(t + 1) * kstep;
            const char* a2 = last ? nA : cA + (size_t)(t + 2) * kstep; const char* b2 = last ? nB : cB + (size_t)(t + 2) * kstep;
            const char* a3 = a2 + kstep; const char* b3 = b2 + kstep;
            PG8_LDB(B0, 0, 0); PG8_SCHED; PG8_LDA(At, 0, 0); PG8_STAGE(PG8_SA(1, 1), a1 + hstep, voffA);
            PG8_WAIT_L(8); PG8_BAR; PG8_WAIT_L(0); PG8_MMA(0, 0, At, B0); PG8_BAR; PG8_SCHED;
            PG8_LDB(B1, 0, 1); PG8_STAGE(PG8_SB(0, 0), b2, voffB);
            PG8_BAR; PG8_WAIT_L(0); PG8_MMA(0, 1, At, B1); PG8_BAR;
            PG8_LDA(At, 0, 1); PG8_STAGE(PG8_SA(0, 0), a2, voffA);
            PG8_BAR; PG8_WAIT_L(0); PG8_MMA(1, 0, At, B0); PG8_BAR; PG8_SCHED;
            PG8_STAGE(PG8_SB(0, 1), b2 + hstep, voffB);
            PG8_WAIT_V(6); PG8_BAR; PG8_MMA(1, 1, At, B1); PG8_BAR;
            PG8_LDB(B0, 1, 0); PG8_SCHED; PG8_LDA(At, 1, 0); PG8_STAGE(PG8_SA(0, 1), a2 + hstep, voffA);
            PG8_WAIT_L(8); PG8_BAR; PG8_WAIT_L(0); PG8_MMA(0, 0, At, B0); PG8_BAR; PG8_SCHED;
            PG8_LDB(B1, 1, 1); PG8_STAGE(PG8_SB(1, 0), b3, voffB);
            PG8_BAR; PG8_WAIT_L(0); PG8_MMA(0, 1, At, B1); PG8_BAR;
            PG8_LDA(At, 1, 1); PG8_STAGE(PG8_SA(1, 0), a3, voffA);
            PG8_BAR; PG8_WAIT_L(0); PG8_MMA(1, 0, At, B0); PG8_BAR; PG8_SCHED;
            PG8_STAGE(PG8_SB(1, 1), b3 + hstep, voffB);
            PG8_WAIT_V(6); PG8_BAR; PG8_MMA(1, 1, At, B1); PG8_BAR;
        }
        E(acc, cur, wr, wc, fr, fq);
        if (!has_next) break;
#pragma unroll
        for (int a = 0; a < 2; ++a)
#pragma unroll
            for (int b = 0; b < 2; ++b)
#pragma unroll
                for (int m = 0; m < 4; ++m)
#pragma unroll
                    for (int n = 0; n < 2; ++n) acc[a][b][m][n] = (f32x4){0.f, 0.f, 0.f, 0.f};
        cur = nxt; cA = nA; cB = nB; ++ui;
    }
    PG8_WAIT_V(0);
    if (wr == 0) PG8_BAR;
    PG8_BAR;
#undef PG8_SA
#undef PG8_SB
#undef PG8_STAGE
#undef PG8_LDA
#undef PG8_LDB
#undef PG8_MMA
#undef PG8_WAIT_V
#undef PG8_WAIT_L
#undef PG8_BAR
#undef PG8_SCHED
}
}

struct TileSched {
  int NF, lo, hi, step;
  __device__ __forceinline__ void init(int nf, int ntiles) { NF = nf; tile_range(ntiles, lo, hi, step); }
  __device__ __forceinline__ bool next(int i, pg8::Unit& u) const {
    const int t = lo + i * step;
    if (t >= hi) return false;
    int ft, tt; tile_decode(t, NF, ft, tt); u.pm = tt; u.pn = ft; return true;
  }
};
typedef f32x4 acc8_t[2][2][4][2];

__device__ void tconv_tile(const float* __restrict__ src, int ldsrc, int k0, int nsrc0, int nvalid,
                           u16* __restrict__ dst, int K, int ndst0, const float* __restrict__ gain, float* sm, int tid, int permg = -1) {
  const int nl = tid & 63, kl0 = tid >> 6;
#pragma unroll
  for (int i = 0; i < 8; i++) {
    int kl = kl0 + 8 * i;
    float v = 0.f;
    if (nl < nvalid) {
      v = src[(size_t)(k0 + kl) * ldsrc + nsrc0 + nl];
      if (gain) v *= gain[k0 + kl];
    }
    sm[kl * 65 + nl] = v;
  }
  __syncthreads();
  const int kl = tid & 63, nl0 = tid >> 6;
#pragma unroll
  for (int i = 0; i < 8; i++) {
    int n = nl0 + 8 * i;
    const int drow = permg >= 0 ? 256 * (permg >> 2) + 128 * (n >> 5) + 32 * (permg & 3) + (n & 31) : ndst0 + n;
    dst[(size_t)drow * K + k0 + kl] = f2bf(sm[kl * 65 + n]);
  }
  __syncthreads();
}

__device__ __forceinline__ void tconv_wave(const float* __restrict__ src, int ldsrc, int k0, int nsrc0, int nvalid,
                                           u16* __restrict__ dst, int K, int ndst0, const float* __restrict__ gain, float* smw, int lane, int permg) {
#pragma unroll 1
  for (int kb = 0; kb < 64; kb += 32) {
    float v[32];
#pragma unroll
    for (int i = 0; i < 32; i++) {
      float t = 0.f;
      if (lane < nvalid) {
        t = src[(size_t)(k0 + kb + i) * ldsrc + nsrc0 + lane];
        if (gain) t *= gain[k0 + kb + i];
      }
      v[i] = t;
    }
#pragma unroll
    for (int i = 0; i < 32; i++) smw[(kb + i) * 65 + lane] = v[i];
  }
#pragma unroll 8
  for (int n = 0; n < 64; n++) {
    const int drow = permg >= 0 ? 256 * (permg >> 2) + 128 * (n >> 5) + 32 * (permg & 3) + (n & 31) : ndst0 + n;
    dst[(size_t)drow * K + k0 + lane] = f2bf(smw[lane * 65 + n]);
  }
}

__device__ __forceinline__ int inproj_src_col(int g) {
  if (g < 33) return g * 64;
  if (g < 89) return 2120 + (g - 33) * 64;
  return 2112;
}

__device__ void phase0(const Params& p, unsigned char* smem) {
  const int tid = threadIdx.x;
  unsigned char* ws = p.ws;
  float* smf = (float*)smem;
  const int NT_IN = 92 * 16, NT_OA = 16 * 8, NT_OUT = 16 * 16, NT_UP = 64 * 16, NT_DN = 16 * 64;
  const int total = NT_IN + 2 * NT_OA + NT_OUT + NT_UP + NT_DN;
  {
    const int lane_ = tid & 63, wave_ = tid >> 6;
    float* smw = smf + wave_ * (64 * 65);
    for (int t = blockIdx.x * 8 + wave_; t < total; t += gridDim.x * 8) {
      int u = t;
      const float* src; int ld, k0, nsrc0, nvalid = 64, K, ndst0, permg = -1; u16* dst; const float* gain = nullptr;
      if (u < NT_IN) {
        const int g = u / 16, kb = u % 16;
        src = p.in[8]; ld = 5704; k0 = kb * 64; nsrc0 = inproj_src_col(g); nvalid = g >= 90 ? 0 : (g == 89 ? 8 : 64);
        dst = (u16*)(ws + OFF_WIN); K = 1024; ndst0 = g * 64; permg = g;
      } else if ((u -= NT_IN) < NT_OA) {
        const int g = u / 8, kb = u % 8; src = p.in[15]; ld = 1024; k0 = kb * 64; nsrc0 = g * 64; dst = (u16*)(ws + OFF_WOA); K = 512; ndst0 = g * 64;
      } else if ((u -= NT_OA) < NT_OA) {
        const int g = u / 8, kb = u % 8; src = p.in[16]; ld = 1024; k0 = kb * 64; nsrc0 = g * 64; dst = (u16*)(ws + OFF_WOB); K = 512; ndst0 = g * 64;
      } else if ((u -= NT_OA) < NT_OUT) {
        const int g = u / 16, kb = u % 16; src = p.in[17]; ld = 1024; k0 = kb * 64; nsrc0 = g * 64; dst = (u16*)(ws + OFF_WOUT); K = 1024; ndst0 = g * 64;
      } else if ((u -= NT_OUT) < NT_UP) {
        const int g = u / 16, kb = u % 16; src = p.in[19]; ld = 4096; k0 = kb * 64; nsrc0 = g * 64; dst = (u16*)(ws + OFF_WUP); K = 1024; ndst0 = g * 64; gain = p.in[18];
      } else {
        u -= NT_UP;
        const int g = u / 64, kb = u % 64; src = p.in[20]; ld = 1024; k0 = kb * 64; nsrc0 = g * 64; dst = (u16*)(ws + OFF_WDN); K = 4096; ndst0 = g * 64;
      }
      tconv_wave(src, ld, k0, nsrc0, nvalid, dst, K, ndst0, gain, smw, lane_, permg);
    }
  }
  {
    const int lane = tid & 63, wave = tid >> 6;
    const float* g = p.in[7];
    u16* XN = (u16*)(ws + OFF_XN);
    const int rstride = gridDim.x * 8;
    for (int row = blockIdx.x * 8 + wave; row < NTOK; row += 2 * rstride) {
      const int row2 = row + rstride;
      const bool has2 = row2 < NTOK;
      const float4* xr = (const float4*)xrow(p, row);
      const float4* xr2 = (const float4*)xrow(p, has2 ? row2 : row);
      float4 v[4], w[4];
      float ss = 0.f, ss2 = 0.f;
#pragma unroll
      for (int i = 0; i < 4; i++) { v[i] = xr[lane + 64 * i]; w[i] = xr2[lane + 64 * i]; }
#pragma unroll
      for (int i = 0; i < 4; i++) {
        ss += v[i].x * v[i].x + v[i].y * v[i].y + v[i].z * v[i].z + v[i].w * v[i].w;
        ss2 += w[i].x * w[i].x + w[i].y * w[i].y + w[i].z * w[i].z + w[i].w * w[i].w;
      }
#pragma unroll
      for (int o = 32; o >= 1; o >>= 1) { ss += __shfl_xor(ss, o); ss2 += __shfl_xor(ss2, o); }
      const float rs = rsqrtf(ss * (1.f / 1024.f) + 1e-6f), rs2 = rsqrtf(ss2 * (1.f / 1024.f) + 1e-6f);
#pragma unroll
      for (int i = 0; i < 4; i++) {
        const float4 gg = ((const float4*)g)[lane + 64 * i];
        uint2 o;
        o.x = pack2(v[i].x * rs * gg.x, v[i].y * rs * gg.y);
        o.y = pack2(v[i].z * rs * gg.z, v[i].w * rs * gg.w);
        *(uint2*)(XN + (size_t)row * 1024 + (lane + 64 * i) * 4) = o;
        if (has2) {
          uint2 o2;
          o2.x = pack2(w[i].x * rs2 * gg.x, w[i].y * rs2 * gg.y);
          o2.y = pack2(w[i].z * rs2 * gg.z, w[i].w * rs2 * gg.w);
          *(uint2*)(XN + (size_t)row2 * 1024 + (lane + 64 * i) * 4) = o2;
        }
      }
    }
  }
  const size_t gtid = (size_t)blockIdx.x * blockDim.x + tid;
  const size_t gsz = (size_t)gridDim.x * blockDim.x;
  {
    float2* CS = (float2*)(ws + OFF_CS);
    for (size_t i = gtid; i < 8192 * 8; i += gsz) {
      int pos = (int)(i >> 3), f = (int)(i & 7);
      float inv = powf(500000.0f, -(float)f / 8.0f);
      float ang = (float)pos * inv;
      double rr = (double)ang;
      rr = rr - 6.283185307179586 * rint(rr * 0.15915494309189535);
      float s, c;
      sincosf((float)rr, &s, &c);
      CS[i] = make_float2(c, s);
    }
    float* rss = (float*)(ws + OFF_ROWSS);
    for (size_t i = gtid; i < NTOK; i += gsz) rss[i] = 0.f;
  }
  {
    u16* KAS = (u16*)(ws + OFF_KAS); u16* VAS = (u16*)(ws + OFF_VAS); u16* KIS = (u16*)(ws + OFF_KIS);
    u16* KBS = (u16*)(ws + OFF_KBS); u16* VBS = (u16*)(ws + OFF_VBS);
    const float* cka = p.in[2]; const float* cva = p.in[3]; const float* cki = p.in[4];
    const float* ckb = p.in[5]; const float* cvb = p.in[6];
#pragma unroll 2
    for (size_t i4 = gtid; i4 < (size_t)8 * 1024 * 512 / 4; i4 += gsz) {
      const size_t i = i4 * 4;
      int d = (int)(i & 63), hd = (int)((i >> 6) & 7), j = (int)((i >> 9) & 1023), bs = (int)(i >> 19);
      const float4 kk4 = *(const float4*)(cka + i);
      const float4 vv4 = *(const float4*)(cva + i);
      uint2 ko; ko.x = pack2(kk4.x, kk4.y); ko.y = pack2(kk4.z, kk4.w);
      *(uint2*)(KAS + ((size_t)(bs * 8 + hd) * 1088 + j) * 64 + d) = ko;
      u16* vd = VAS + (size_t)(bs * 8 + hd) * 64 * 1088 + (size_t)(j >> 6) * 4096 + d * 64 + (j & 63);
      vd[0] = f2bf(vv4.x); vd[64] = f2bf(vv4.y); vd[2 * 64] = f2bf(vv4.z); vd[3 * 64] = f2bf(vv4.w);
    }
    for (size_t i4 = gtid; i4 < (size_t)8 * 1024 * 64 / 4; i4 += gsz) {
      const size_t i = i4 * 4;
      int d = (int)(i & 63), j = (int)((i >> 6) & 1023), bs = (int)(i >> 16);
      const float4 kk4 = *(const float4*)(cki + i);
      uint2 ko; ko.x = pack2(kk4.x, kk4.y); ko.y = pack2(kk4.z, kk4.w);
      *(uint2*)(KIS + ((size_t)bs * 1088 + j) * 64 + d) = ko;
    }
#pragma unroll 2
    for (size_t i4 = gtid; i4 < (size_t)8 * 512 * 512 / 4; i4 += gsz) {
      const size_t i = i4 * 4;
      int d = (int)(i & 63), hd = (int)((i >> 6) & 7), j = (int)((i >> 9) & 511), bs = (int)(i >> 18);
      const float4 kk4 = *(const float4*)(ckb + i);
      const float4 vv4 = *(const float4*)(cvb + i);
      uint2 ko; ko.x = pack2(kk4.x, kk4.y); ko.y = pack2(kk4.z, kk4.w);
      *(uint2*)(KBS + ((size_t)(bs * 8 + hd) * 576 + j) * 64 + d) = ko;
      u16* vd = VBS + (size_t)(bs * 8 + hd) * 64 * 576 + (size_t)(j >> 6) * 4096 + d * 64 + (j & 63);
      vd[0] = f2bf(vv4.x); vd[64] = f2bf(vv4.y); vd[2 * 64] = f2bf(vv4.z); vd[3 * 64] = f2bf(vv4.w);
    }
  }
}

template <int AI>
__device__ __forceinline__ void epi_inproj(const Params& p, const acc8_t& acc, int g, int tbase, int fr, int fq) {
  unsigned char* ws = p.ws;
  const bool sample = tbase >= NPROMPT;
  int b, trow;
  if (!sample) { b = tbase >> 13; trow = tbase & 8191; } else { b = (tbase - NPROMPT) >> 6; trow = 0; }
  const float* gain = nullptr; bool rope = false, sig = false;
  u16* bdst = nullptr; size_t brow0 = 0; int bld = 0, bcol = 0;
  u16* vdst = nullptr; int vS = 0, vcol0 = 0;
  float* fdst = nullptr; size_t frow0 = 0; int fld = 0, fcol = 0;
  bool wi = false;
  if (g < 8) { gain = p.in[9]; rope = true; bdst = (u16*)(ws + OFF_QA); brow0 = tbase; bld = 512; bcol = g * 64; }
  else if (g < 16) {
    int hd = g - 8; gain = p.in[10]; rope = true; bld = 64;
    if (!sample) { bdst = (u16*)(ws + OFF_KAP) + (size_t)(b * 8 + hd) * 8192 * 64; brow0 = trow; fdst = p.out + O_KAP; frow0 = tbase; }
    else { bdst = (u16*)(ws + OFF_KAS) + (size_t)(b * 8 + hd) * 1088 * 64; brow0 = 1024; fdst = p.out + O_KAS; frow0 = b * 64; }
    fld = 512; fcol = hd * 64;
  } else if (g < 24) {
    int hd = g - 16;
    if (!sample) { vdst = (u16*)(ws + OFF_VAP) + (size_t)(b * 8 + hd) * 64 * 8192; vS = 8192; vcol0 = trow; fdst = p.out + O_VAP; frow0 = tbase; }
    else { vdst = (u16*)(ws + OFF_VAS) + (size_t)(b * 8 + hd) * 64 * 1088; vS = 1088; vcol0 = 1024; fdst = p.out + O_VAS; frow0 = b * 64; }
    fld = 512; fcol = hd * 64;
  } else if (g < 32) { rope = true; bdst = (u16*)(ws + OFF_QI); brow0 = tbase; bld = 512; bcol = (g - 24) * 64; }
  else if (g == 32) {
    gain = p.in[11]; rope = true; bld = 64; fld = 64;
    if (!sample) { bdst = (u16*)(ws + OFF_KIP) + (size_t)b * 8192 * 64; brow0 = trow; fdst = p.out + O_KIP; frow0 = tbase; }
    else { bdst = (u16*)(ws + OFF_KIS) + (size_t)b * 1088 * 64; brow0 = 1024; fdst = p.out + O_KIS; frow0 = b * 64; }
  } else if (g < 41) { gain = p.in[12]; bdst = (u16*)(ws + OFF_QB); brow0 = tbase; bld = 512; bcol = (g - 33) * 64; }
  else if (g < 49) {
    int hd = g - 41; gain = p.in[13]; bld = 64; fld = 512; fcol = hd * 64;
    if (!sample) {
      bdst = (u16*)(ws + OFF_KBP) + (size_t)(b * 8 + hd) * 8192 * 64; brow0 = trow;
      if (trow >= 7680) { fdst = p.out + O_KBP; frow0 = b * 512 + (trow - 7680); }
    } else { bdst = (u16*)(ws + OFF_KBS) + (size_t)(b * 8 + hd) * 576 * 64; brow0 = 512; fdst = p.out + O_KBS; frow0 = b * 64; }
  } else if (g < 57) {
    int hd = g - 49; fld = 512; fcol = hd * 64;
    if (!sample) {
      vdst = (u16*)(ws + OFF_VBP) + (size_t)(b * 8 + hd) * 64 * 8192; vS = 8192; vcol0 = trow;
      if (trow >= 7680) { fdst = p.out + O_VBP; frow0 = b * 512 + (trow - 7680); }
    } else { vdst = (u16*)(ws + OFF_VBS) + (size_t)(b * 8 + hd) * 64 * 576; vS = 576; vcol0 = 512; fdst = p.out + O_VBS; frow0 = b * 64; }
  } else if (g < 73) { sig = true; bdst = (u16*)(ws + OFF_GA); brow0 = tbase; bld = 1024; bcol = (g - 57) * 64; }
  else if (g < 89) { sig = true; bdst = (u16*)(ws + OFF_GB); brow0 = tbase; bld = 1024; bcol = (g - 73) * 64; }
  else wi = true;

  float4 gg[2][2];
  if (gain) {
#pragma unroll
    for (int bj = 0; bj < 2; bj++)
#pragma unroll
      for (int n = 0; n < 2; n++) gg[bj][n] = *(const float4*)(gain + 32 * bj + 16 * n + 4 * fq);
  }
#pragma unroll
  for (int m = 0; m < 4; m++) {
    const int tl = 16 * m + fr;
    float x[16];
#pragma unroll
    for (int bj = 0; bj < 2; bj++)
#pragma unroll
      for (int n = 0; n < 2; n++)
#pragma unroll
        for (int j = 0; j < 4; j++) x[(bj * 2 + n) * 4 + j] = acc[AI][bj][m][n][j];
    if (wi) {
      if (fq < 2) *(float4*)((float*)(ws + OFF_WI) + (size_t)(tbase + tl) * 8 + 4 * fq) = make_float4(x[0], x[1], x[2], x[3]);
      continue;
    }
    if (gain) {
      float ss = 0.f;
#pragma unroll
      for (int k = 0; k < 16; k++) ss += x[k] * x[k];
      ss = xsum16(ss);
      ss = xsum32(ss);
      const float rs = rsqrtf(ss * (1.f / 64.f) + 1e-6f);
#pragma unroll
      for (int bj = 0; bj < 2; bj++)
#pragma unroll
        for (int n = 0; n < 2; n++) {
          x[(bj * 2 + n) * 4 + 0] *= rs * gg[bj][n].x; x[(bj * 2 + n) * 4 + 1] *= rs * gg[bj][n].y;
          x[(bj * 2 + n) * 4 + 2] *= rs * gg[bj][n].z; x[(bj * 2 + n) * 4 + 3] *= rs * gg[bj][n].w;
        }
    }
    if (rope) {
      const int pos = sample ? 1024 + tl : trow + tl;
      const float4* cs = (const float4*)((const float2*)(ws + OFF_CS) + (size_t)pos * 8 + 4 * (fq & 1));
      const float4 c01 = cs[0], c23 = cs[1];
      const float cc[4] = {c01.x, c01.z, c23.x, c23.z};
      const float sn[4] = {c01.y, c01.w, c23.y, c23.w};
#pragma unroll
      for (int j = 0; j < 4; j++) {
        const float other = xother32(x[j], fq < 2);
        x[j] = (fq < 2) ? x[j] * cc[j] - other * sn[j] : x[j] * cc[j] + other * sn[j];
      }
    }
    if (sig) {
#pragma unroll
      for (int k = 0; k < 16; k++) x[k] = __builtin_amdgcn_rcpf(1.f + __builtin_amdgcn_exp2f(-LOG2E * x[k]));
    }
    if (bdst) {
      u16* d = bdst + (brow0 + tl) * (size_t)bld + bcol;
#pragma unroll
      for (int bj = 0; bj < 2; bj++)
#pragma unroll
        for (int n = 0; n < 2; n++) {
          uint2 o;
          o.x = pack2(x[(bj * 2 + n) * 4 + 0], x[(bj * 2 + n) * 4 + 1]);
          o.y = pack2(x[(bj * 2 + n) * 4 + 2], x[(bj * 2 + n) * 4 + 3]);
          *(uint2*)(d + 32 * bj + 16 * n + 4 * fq) = o;
        }
    }
    if (vdst) {
      const int q = fr & 3;
      const bool q1 = (q & 1) != 0, q2 = (q & 2) != 0;
#define DPPX(v, ctrl) __int_as_float(__builtin_amdgcn_update_dpp(0, __float_as_int(v), ctrl, 0xf, 0xf, true))
#pragma unroll
      for (int bj = 0; bj < 2; bj++)
#pragma unroll
        for (int n = 0; n < 2; n++) {
          float r0 = x[(bj * 2 + n) * 4 + 0], r1 = x[(bj * 2 + n) * 4 + 1], r2 = x[(bj * 2 + n) * 4 + 2], r3 = x[(bj * 2 + n) * 4 + 3];
          { const float s01 = q1 ? r0 : r1, g01 = DPPX(s01, 0xB1); if (q1) r0 = g01; else r1 = g01;
            const float s23 = q1 ? r2 : r3, g23 = DPPX(s23, 0xB1); if (q1) r2 = g23; else r3 = g23; }
          { const float s02 = q2 ? r0 : r2, g02 = DPPX(s02, 0x4E); if (q2) r0 = g02; else r2 = g02;
            const float s13 = q2 ? r1 : r3, g13 = DPPX(s13, 0x4E); if (q2) r1 = g13; else r3 = g13; }
          const int f = 32 * bj + 16 * n + 4 * fq + q;
          uint2 o; o.x = pack2(r0, r1); o.y = pack2(r2, r3);
          *(uint2*)(vdst + (size_t)(vcol0 >> 6) * 4096 + f * 64 + 16 * m + 4 * (fr >> 2)) = o;
        }
#undef DPPX
    }
    if (fdst) {
      float* d = fdst + (frow0 + tl) * (size_t)fld + fcol;
#pragma unroll
      for (int bj = 0; bj < 2; bj++)
#pragma unroll
        for (int n = 0; n < 2; n++)
          { f32x4 v_ = {x[(bj * 2 + n) * 4 + 0], x[(bj * 2 + n) * 4 + 1], x[(bj * 2 + n) * 4 + 2], x[(bj * 2 + n) * 4 + 3]};
            __builtin_nontemporal_store(v_, (f32x4*)(d + 32 * bj + 16 * n + 4 * fq)); }
    }
  }
}

struct EpiInproj {
  const Params& p;
  __device__ __forceinline__ void operator()(const acc8_t& acc, const pg8::Unit& u, int wr, int wc, int fr, int fq) const {
    const int g = u.pn * 4 + wc;
    if (g >= 90) return;
    int fr_ = fr, fq_ = fq;
    asm volatile("" : "+v"(fr_), "+v"(fq_));
    epi_inproj<0>(p, acc, g, u.pm * 256 + 64 * wr, fr_, fq_);
    asm volatile("" : "+v"(fr_), "+v"(fq_));
    epi_inproj<1>(p, acc, g, u.pm * 256 + 128 + 64 * wr, fr_, fq_);
  }
};

__device__ void phase1(const Params& p, unsigned char* smem) {
  TileSched S; S.init(23, 23 * 130);
  pg8::Gemm g; g.A = (const u16*)(p.ws + OFF_XN); g.Bt = (const u16*)(p.ws + OFF_WIN); g.K = 1024;
  EpiInproj E{p};
  pg8::gemm_phase(( PG8_LAS unsigned char*)smem, g, S, E);
}

#define P2_LOADCHUNK(c, A0, B0, A1, B1, A2, B2, A3, B3)                          \
  {                                                                              \
    const u16* kr_ = kbase + (size_t)(c) * 4096;                                 \
    A0 = as_bf8(*(const uint4*)(kr_));        B0 = as_bf8(*(const uint4*)(kr_ + 32));        \
    A1 = as_bf8(*(const uint4*)(kr_ + 1024)); B1 = as_bf8(*(const uint4*)(kr_ + 1024 + 32)); \
    A2 = as_bf8(*(const uint4*)(kr_ + 2048)); B2 = as_bf8(*(const uint4*)(kr_ + 2048 + 32)); \
    A3 = as_bf8(*(const uint4*)(kr_ + 3072)); B3 = as_bf8(*(const uint4*)(kr_ + 3072 + 32)); \
  }
#define P2_SCORE(K0, K1, kg)                                                     \
  {                                                                              \
    _Pragma("unroll") for (int pp = 0; pp < 4; pp++) {                           \
      f32x4 a_ = {0.f, 0.f, 0.f, 0.f};                                           \
      a_ = mfma16(qa[pp][0], K0, a_);                                            \
      a_ = mfma16(qa[pp][1], K1, a_);                                            \
      float s_ = wv[pp].x * fmaxf(a_[0], 0.f) + wv[pp].y * fmaxf(a_[1], 0.f) + wv[pp].z * fmaxf(a_[2], 0.f) + wv[pp].w * fmaxf(a_[3], 0.f); \
      { auto r_ = __builtin_amdgcn_permlane16_swap(__float_as_uint(s_), __float_as_uint(s_), false, false); \
        s_ = __uint_as_float(r_[0]) + __uint_as_float(r_[1]); }                  \
      if ((g4 & 1) == 0) {                                                       \
        _Float16 hv_ = (_Float16)s_;                                             \
        u16 bits_ = __builtin_bit_cast(u16, hv_);                                \
        bits_ ^= (bits_ & 0x8000) ? (u16)0xFFFF : (u16)0x8000;                   \
        sc[2 * pp + (g4 >> 1)][(kg) * 16 + n16] = bits_;                         \
      }                                                                          \
    }                                                                            \
  }
#define P2_COUNT(mh_, cnt_)                                                      \
  {                                                                              \
    uint32_t c_ = 0;                                                             \
    _Pragma("unroll") for (int j = 0; j < 16; j++) if (j < nv512) {              \
      c_ += (v[j].x >= mh_) + ((v[j].x << 16) >= mh_);                           \
      c_ += (v[j].y >= mh_) + ((v[j].y << 16) >= mh_);                           \
      c_ += (v[j].z >= mh_) + ((v[j].z << 16) >= mh_);                           \
      c_ += (v[j].w >= mh_) + ((v[j].w << 16) >= mh_);                           \
    }                                                                            \
    _Pragma("unroll") for (int o_ = 32; o_ >= 1; o_ >>= 1) c_ += __shfl_xor(c_, o_); \
    cnt_ = (int)c_;                                                              \
  }

__device__ void phase2(const Params& p, unsigned char* smem) {
  u16 (*sc)[8192] = (u16 (*)[8192])smem;
  unsigned char* ws = p.ws;
  const int tid = threadIdx.x, lane = tid & 63, wave = tid >> 6;
  const int NTILE = 4096 + 64;
  for (int it = blockIdx.x; it < NTILE; it += gridDim.x) {
    const int rr = it >> 8, ww = it & 255;
    const int idx = (rr & 1) ? (rr << 8) + 255 - ww : it;
    int tok0, nvis; const u16* KI; u64* mrow0; int mld;
    if (idx < 4096) {
      int b = idx & 3, j8 = 1023 - (idx >> 2);
      int q0 = j8 * 8;
      tok0 = b * 8192 + q0; nvis = ((q0 >> 6) + 1) * 64;
      KI = (const u16*)(ws + OFF_KIP) + (size_t)b * 8192 * 64;
      mrow0 = (u64*)(ws + OFF_MASKP) + (size_t)tok0 * 128; mld = 128;
    } else {
      int s = idx - 4096; int b = s >> 3, q0 = (s & 7) * 8;
      tok0 = NPROMPT + b * 64 + q0; nvis = 1088;
      KI = (const u16*)(ws + OFF_KIS) + (size_t)b * 1088 * 64;
      mrow0 = (u64*)(ws + OFF_MASKS) + (size_t)(b * 64 + q0) * 32; mld = 32;
    }
    const int nv512 = (nvis + 511) >> 9;
    {
      const int tail = nv512 * 512 - nvis;
      for (int e = tid; e < 8 * tail; e += 512) { int q = e / tail, k = e % tail; sc[q][nvis + k] = 0; }
    }
    const u16* QI = (const u16*)(ws + OFF_QI);
    const float* WI = (const float*)(ws + OFF_WI);
    const int n16 = lane & 15, g4 = lane >> 4;
    bf16x8 qa[4][2]; float4 wv[4];
#pragma unroll
    for (int pp = 0; pp < 4; pp++) {
      const int ql = 2 * pp + (n16 >> 3), hh = n16 & 7;
#pragma unroll
      for (int kh = 0; kh < 2; kh++)
        qa[pp][kh] = as_bf8(*(const uint4*)(QI + (size_t)(tok0 + ql) * 512 + hh * 64 + kh * 32 + 8 * g4));
      wv[pp] = *(const float4*)(WI + (size_t)(tok0 + 2 * pp + (g4 >> 1)) * 8 + 4 * (g4 & 1));
    }
    {
      const int nchunk = nvis >> 6;
      const u16* kbase = KI + (size_t)n16 * 64 + 8 * g4;
      bf16x8 nA0, nB0, nA1, nB1, nA2, nB2, nA3, nB3;
      int c = wave;
      if (c < nchunk) P2_LOADCHUNK(c, nA0, nB0, nA1, nB1, nA2, nB2, nA3, nB3)
      for (; c < nchunk; c += 8) {
        bf16x8 cA0 = nA0, cB0 = nB0, cA1 = nA1, cB1 = nB1, cA2 = nA2, cB2 = nB2, cA3 = nA3, cB3 = nB3;
        if (c + 8 < nchunk) P2_LOADCHUNK(c + 8, nA0, nB0, nA1, nB1, nA2, nB2, nA3, nB3)
        __builtin_amdgcn_sched_barrier(0);
        P2_SCORE(cA0, cB0, c * 4 + 0)
        P2_SCORE(cA1, cB1, c * 4 + 1)
        P2_SCORE(cA2, cB2, c * 4 + 2)
        P2_SCORE(cA3, cB3, c * 4 + 3)
      }
    }
    __syncthreads();
    {
      const u16* my = sc[wave];
      uint32_t T = 0, need_eq = 0;
      if (nvis > 256) {
        uint32_t* hist = (uint32_t*)(smem + 131072) + wave * 256;
        uint32_t Bsel = 0, above = 0;
#pragma unroll
        for (int pass = 0; pass < 2; pass++) {
          *(uint4*)(hist + lane * 4) = make_uint4(0u, 0u, 0u, 0u);
          __builtin_amdgcn_fence(__ATOMIC_RELEASE, "wavefront");
          {
            uint4 cur = *(const uint4*)(my + lane * 8);
            for (int j = 0; j < nv512; j++) {
              uint4 nxt = cur;
              if (j + 1 < nv512) nxt = *(const uint4*)(my + ((j + 1) * 64 + lane) * 8);
#pragma unroll
              for (int e = 0; e < 8; e++) {
                const uint32_t w = (e >> 1) == 0 ? cur.x : ((e >> 1) == 1 ? cur.y : ((e >> 1) == 2 ? cur.z : cur.w));
                const uint32_t k = (e & 1) ? (w >> 16) : (w & 0xFFFFu);
                if (pass == 0) atomicAdd(hist + (k >> 8), 1u);
                else if ((k >> 8) == Bsel) atomicAdd(hist + (k & 255u), 1u);
              }
              cur = nxt;
            }
          }
          __builtin_amdgcn_fence(__ATOMIC_ACQ_REL, "wavefront");
          uint4 hh; { const volatile uint32_t* hv_ = hist + lane * 4; hh.x = hv_[0]; hh.y = hv_[1]; hh.z = hv_[2]; hh.w = hv_[3]; }
          const uint32_t target = 256u - above;
          const uint32_t ssum = hh.x + hh.y + hh.z + hh.w;
          uint32_t suf = ssum;
#pragma unroll
          for (int o = 1; o < 64; o <<= 1) { uint32_t t = __shfl_down(suf, o); if (lane + o < 64) suf += t; }
          const uint32_t excl = suf - ssum;
          const bool hit = (excl < target) && (suf >= target);
          uint32_t bl = 0, ab = 0;
          {
            const uint32_t c3 = excl + hh.w, c2 = c3 + hh.z, c1 = c2 + hh.y;
            if (c3 >= target) { bl = 3; ab = excl; }
            else if (c2 >= target) { bl = 2; ab = c3; }
            else if (c1 >= target) { bl = 1; ab = c2; }
            else { bl = 0; ab = c1; }
          }
          const u64 hb = __ballot(hit);
          const int src = hb ? (int)__builtin_ctzll(hb) : 0;
          const uint32_t binsel = (uint32_t)__shfl((int)(lane * 4 + bl), src);
          const uint32_t absel = (uint32_t)__shfl((int)ab, src);
          if (pass == 0) { Bsel = binsel; above = absel; }
          else { T = (Bsel << 8) | binsel; need_eq = 256u - (above + absel); }
        }
      }
      u64* mrow = mrow0 + (size_t)wave * mld;
      uint32_t eq_seen = 0;
      const u64 ltmask = (1ull << lane) - 1ull;
      uint4 cur = *(const uint4*)(my + lane * 8);
      for (int j = 0; j < nv512; j++) {
        uint4 nxt = cur;
        if (j + 1 < nv512) nxt = *(const uint4*)(my + ((j + 1) * 64 + lane) * 8);
        u64 myword = 0;
#pragma unroll
        for (int e = 0; e < 8; e++) {
          const uint32_t w = (e >> 1) == 0 ? cur.x : ((e >> 1) == 1 ? cur.y : ((e >> 1) == 2 ? cur.z : cur.w));
          const uint32_t k = (e & 1) ? (w >> 16) : (w & 0xFFFFu);
          const bool gt = k > T, eq = (k == T);
          const u64 beq = __ballot(eq);
          const uint32_t rank = __popcll(beq & ltmask);
          const bool sel = gt || (eq && (eq_seen + rank) < need_eq);
          const u64 m = __ballot(sel);
          eq_seen += __popcll(beq);
          if (lane == e) myword = m;
        }
        if (lane < 8) mrow[j * 8 + lane] = myword;
        cur = nxt;
      }
    }
    __syncthreads();
  }
}

struct AttnSmem { u16 K[2][64][72]; u16 VT[2][64][72]; float bias[264]; };

__device__ __forceinline__ void attn_tile(const bool BAND, AttnSmem& sm, u16* Qg, int qtok0, int hd, int nw, const u16* __restrict__ Kg,
                          const u16* __restrict__ VTg, int S, int qloc0, const u64* maskrow0, int mld,
                          const float* bias_tab, int tid, const bool dry = false) {
  const int lane = tid & 63, wave = tid >> 6;
  const int r = lane & 31, h = lane >> 5;
  const bool wact = wave < nw;
  const int wq0 = qloc0 + 32 * wave;
  const int cw = wq0 >> 6;
  const int c_first = qloc0 >> 6, c_last = (qloc0 + 32 * (nw - 1)) >> 6;
  const int kt_lo = BAND ? (c_first - 8 > 0 ? c_first - 8 : 0) : 0;
  if (BAND) {
    for (int e = tid; e < 257; e += 512) sm.bias[e] = bias_tab[e * 8 + hd] * LOG2E;
  }
  bf16x8 qf0, qf1, qf2, qf3;
  u16* qrow = Qg + (size_t)(qtok0 + 32 * wave + r) * 512 + hd * 64;
  const float csc = 0.125f * LOG2E;
  if (wact) {
#define LOADQ(dst, kk)                                                              \
    { uint4 t_ = *(const uint4*)(qrow + (kk) * 16 + h * 8);                          \
      t_.x = pack2(bflo(t_.x) * csc, bfhi(t_.x) * csc); t_.y = pack2(bflo(t_.y) * csc, bfhi(t_.y) * csc); \
      t_.z = pack2(bflo(t_.z) * csc, bfhi(t_.z) * csc); t_.w = pack2(bflo(t_.w) * csc, bfhi(t_.w) * csc); \
      dst = as_bf8(t_); }
    LOADQ(qf0, 0) LOADQ(qf1, 1) LOADQ(qf2, 2) LOADQ(qf3, 3)
#undef LOADQ
  }
  const bool usemask = !BAND && wact;
  const u64* mrow = usemask ? maskrow0 + (size_t)(32 * wave + r) * mld + 4 * h : nullptr;
  u64 mw0 = 0, mw1 = 0, mw2 = 0, mw3 = 0, nx0 = 0, nx1 = 0, nx2 = 0, nx3 = 0;
  if (usemask) { nx0 = mrow[0]; nx1 = mrow[1]; nx2 = mrow[2]; nx3 = mrow[3]; }
  f32x16 o0, o1;
#pragma unroll
  for (int i = 0; i < 16; i++) { o0[i] = 0.f; o1[i] = 0.f; }
  float lsum = 0.f;
  const int lrow = tid >> 3, lcol = (tid & 7) * 8;
  const u16* kptr = Kg + (size_t)(kt_lo * 64 + lrow) * 64 + lcol;
  const u16* vptr = VTg + (size_t)kt_lo * 4096 + lrow * 64 + lcol;
  uint4 kv = *(const uint4*)kptr;
  uint4 vv = *(const uint4*)vptr;
  *(uint4*)&sm.K[0][lrow][lcol] = kv;
  *(uint4*)&sm.VT[0][lrow][lcol] = vv;
  if (kt_lo < c_last) {
    kptr += 64 * 64; vptr += 4096;
    kv = *(const uint4*)kptr;
    vv = *(const uint4*)vptr;
  }
  __syncthreads();
  for (int kt = kt_lo; kt <= c_last; kt++) {
    const int cur = (kt - kt_lo) & 1;
    if (kt < c_last) {
      *(uint4*)&sm.K[cur ^ 1][lrow][lcol] = kv;
      *(uint4*)&sm.VT[cur ^ 1][lrow][lcol] = vv;
      if (kt + 1 < c_last) {
        kptr += 64 * 64; vptr += 4096;
        kv = *(const uint4*)kptr;
        vv = *(const uint4*)vptr;
      }
    }
    if (usemask) {
      if ((kt & 7) == 0) { mw0 = nx0; mw1 = nx1; mw2 = nx2; mw3 = nx3; }
      if ((kt & 7) == 1 && kt + 7 <= cw) {
        const u64* mn = mrow + ((kt >> 3) + 1) * 8;
        nx0 = mn[0]; nx1 = mn[1]; nx2 = mn[2]; nx3 = mn[3];
      }
    }
    __builtin_amdgcn_sched_barrier(0);
    const bool act = wact && kt <= cw && (!BAND || kt >= cw - 8);
    if (act) {
      const int bsh = (kt & 7) * 8;
      uint32_t mb[4];
      mb[0] = (uint32_t)(mw0 >> bsh) & 0xFFu; mb[1] = (uint32_t)(mw1 >> bsh) & 0xFFu;
      mb[2] = (uint32_t)(mw2 >> bsh) & 0xFFu; mb[3] = (uint32_t)(mw3 >> bsh) & 0xFFu;
#pragma unroll
      for (int sb = 0; sb < 2; sb++) {
        f32x16 s;
#pragma unroll
        for (int i = 0; i < 16; i++) s[i] = 0.f;
        s = mfma32(*(const bf16x8*)&sm.K[cur][sb * 32 + r][0 * 16 + h * 8], qf0, s);
        s = mfma32(*(const bf16x8*)&sm.K[cur][sb * 32 + r][1 * 16 + h * 8], qf1, s);
        s = mfma32(*(const bf16x8*)&sm.K[cur][sb * 32 + r][2 * 16 + h * 8], qf2, s);
        s = mfma32(*(const bf16x8*)&sm.K[cur][sb * 32 + r][3 * 16 + h * 8], qf3, s);
        float pv[16];
        if (BAND) {
          const int qpos = wq0 + r;
          if (kt <= cw - 3) {
            const float bb = sm.bias[256];
#pragma unroll
            for (int i = 0; i < 16; i++) pv[i] = __builtin_amdgcn_exp2f(s[i] + bb);
          } else {
#pragma unroll
            for (int i = 0; i < 16; i++) {
              int kpos = kt * 64 + sb * 32 + (i & 3) + 8 * (i >> 2) + 4 * h;
              int dd = qpos - kpos;
              dd = dd < -128 ? -128 : (dd > 128 ? 128 : dd);
              pv[i] = __builtin_amdgcn_exp2f(s[i] + sm.bias[dd + 128]);
            }
          }
        } else {
#pragma unroll
          for (int i = 0; i < 16; i++) {
            const int bit = sb * 4 + (i >> 2);
            const float e = __builtin_amdgcn_exp2f(s[i]);
            const int m = __builtin_amdgcn_sbfe((int)mb[i & 3], bit, 1);
            pv[i] = __uint_as_float(__float_as_uint(e) & (uint32_t)m);
          }
        }
#pragma unroll
        for (int i = 0; i < 16; i++) lsum += pv[i];
#pragma unroll
        for (int st = 0; st < 2; st++) {
          union { uint32_t u[4]; bf16x8 b; } pf;
#pragma unroll
          for (int j = 0; j < 4; j++) pf.u[j] = pack2(pv[8 * st + 2 * j], pv[8 * st + 2 * j + 1]);
          union { uint2 u[2]; bf16x8 b; } v0, v1;
          const int kc = sb * 32 + 16 * st + 4 * h;
          v0.u[0] = *(const uint2*)&sm.VT[cur][r][kc];
          v0.u[1] = *(const uint2*)&sm.VT[cur][r][kc + 8];
          v1.u[0] = *(const uint2*)&sm.VT[cur][32 + r][kc];
          v1.u[1] = *(const uint2*)&sm.VT[cur][32 + r][kc + 8];
          o0 = mfma32(v0.b, pf.b, o0);
          o1 = mfma32(v1.b, pf.b, o1);
        }
      }
    }
    __syncthreads();
  }
  if (wact && (!dry || lsum == 12345.678f)) {
    lsum += __shfl_xor(lsum, 32);
    const float inv = 1.f / lsum;
#pragma unroll
    for (int q4 = 0; q4 < 4; q4++) {
      uint2 a, b;
      a.x = pack2(o0[q4 * 4 + 0] * inv, o0[q4 * 4 + 1] * inv);
      a.y = pack2(o0[q4 * 4 + 2] * inv, o0[q4 * 4 + 3] * inv);
      b.x = pack2(o1[q4 * 4 + 0] * inv, o1[q4 * 4 + 1] * inv);
      b.y = pack2(o1[q4 * 4 + 2] * inv, o1[q4 * 4 + 3] * inv);
      *(uint2*)(qrow + q4 * 8 + 4 * h) = a;
      *(uint2*)(qrow + 32 + q4 * 8 + 4 * h) = b;
    }
  }
  __syncthreads();
}

__device__ void phase3(const Params& p, unsigned char* smem, const bool dry = false) {
  AttnSmem& sm = *(AttnSmem*)smem;
  unsigned char* ws = p.ws;
  const int tid = threadIdx.x;
  const int NITEM = 1024 + 1024 + 64 + 64;
  for (int it = blockIdx.x; it < NITEM; it += gridDim.x) {
    bool band; int qtok0, hd, nw, S, qloc0, mld = 0; u16* Qg; const u16* Kg; const u16* VTg; const u64* mrow0 = nullptr;
    if (it < 1024) {
      const int rr = it >> 8, ww = it & 255;
      const int w2 = (rr & 1) ? 255 - ww : ww;
      const int j = 31 - (rr * 8 + (w2 >> 5)), bh = w2 & 31;
      const int b = bh >> 3; hd = bh & 7;
      band = false; Qg = (u16*)(ws + OFF_QA); qtok0 = b * 8192 + j * 256; nw = 8; S = 8192; qloc0 = j * 256;
      Kg = (const u16*)(ws + OFF_KAP) + (size_t)(b * 8 + hd) * 8192 * 64;
      VTg = (const u16*)(ws + OFF_VAP) + (size_t)(b * 8 + hd) * 64 * 8192;
      mrow0 = (const u64*)(ws + OFF_MASKP) + (size_t)(b * 8192 + j * 256) * 128; mld = 128;
    } else if (it < 2048) {
      const int u = it - 1024;
      const int j = u >> 5, bh = u & 31;
      const int b = bh >> 3; hd = bh & 7;
      band = true; Qg = (u16*)(ws + OFF_QB); qtok0 = b * 8192 + j * 256; nw = 8; S = 8192; qloc0 = j * 256;
      Kg = (const u16*)(ws + OFF_KBP) + (size_t)(b * 8 + hd) * 8192 * 64;
      VTg = (const u16*)(ws + OFF_VBP) + (size_t)(b * 8 + hd) * 64 * 8192;
    } else if (it < 2048 + 64) {
      const int u = it - 2048;
      const int b = u >> 3; hd = u & 7;
      band = false; Qg = (u16*)(ws + OFF_QA); qtok0 = NPROMPT + b * 64; nw = 2; S = 1088; qloc0 = 1024;
      Kg = (const u16*)(ws + OFF_KAS) + (size_t)(b * 8 + hd) * 1088 * 64;
      VTg = (const u16*)(ws + OFF_VAS) + (size_t)(b * 8 + hd) * 64 * 1088;
      mrow0 = (const u64*)(ws + OFF_MASKS) + (size_t)(b * 64) * 32; mld = 32;
    } else {
      const int u = it - 2048 - 64;
      const int b = u >> 3; hd = u & 7;
      band = true; Qg = (u16*)(ws + OFF_QB); qtok0 = NPROMPT + b * 64; nw = 2; S = 576; qloc0 = 512;
      Kg = (const u16*)(ws + OFF_KBS) + (size_t)(b * 8 + hd) * 576 * 64;
      VTg = (const u16*)(ws + OFF_VBS) + (size_t)(b * 8 + hd) * 64 * 576;
    }
    attn_tile(band, sm, Qg, qtok0, hd, nw, Kg, VTg, S, qloc0, mrow0, mld, p.in[14], tid, dry);
  }
}

#define EPI_TOKEN(u, ai, m) ((size_t)((u).pm * 256 + 128 * (ai) + 64 * wr + 16 * (m) + fr))
#define EPI_COL(u, bj, n) ((u).pn * 256 + 128 * (bj) + 32 * wc + 16 * (n) + 4 * fq)

struct EpiGateA {
  unsigned char* ws;
  __device__ __forceinline__ void operator()(const acc8_t& acc, const pg8::Unit& u, int wr, int wc, int fr, int fq) const {
    const u16* GA = (const u16*)(ws + OFF_GA); u16* M = (u16*)(ws + OFF_M);
#pragma unroll
    for (int ai = 0; ai < 2; ai++)
#pragma unroll
      for (int m = 0; m < 4; m++) {
        const size_t token = EPI_TOKEN(u, ai, m);
#pragma unroll
        for (int bj = 0; bj < 2; bj++)
#pragma unroll
          for (int n = 0; n < 2; n++) {
            const int f = EPI_COL(u, bj, n);
            const uint2 ga = *(const uint2*)(GA + token * 1024 + f);
            uint2 o;
            o.x = pack2(bflo(ga.x) * acc[ai][bj][m][n][0], bfhi(ga.x) * acc[ai][bj][m][n][1]);
            o.y = pack2(bflo(ga.y) * acc[ai][bj][m][n][2], bfhi(ga.y) * acc[ai][bj][m][n][3]);
            *(uint2*)(M + token * 1024 + f) = o;
          }
      }
  }
};
struct EpiGateB {
  unsigned char* ws;
  __device__ __forceinline__ void operator()(const acc8_t& acc, const pg8::Unit& u, int wr, int wc, int fr, int fq) const {
    const u16* GB = (const u16*)(ws + OFF_GB); u16* M = (u16*)(ws + OFF_M);
#pragma unroll
    for (int ai = 0; ai < 2; ai++)
#pragma unroll
      for (int m = 0; m < 4; m++) {
        const size_t token = EPI_TOKEN(u, ai, m);
#pragma unroll
        for (int bj = 0; bj < 2; bj++)
#pragma unroll
          for (int n = 0; n < 2; n++) {
            const int f = EPI_COL(u, bj, n);
            const uint2 gb = *(const uint2*)(GB + token * 1024 + f);
            const uint2 mo = *(const uint2*)(M + token * 1024 + f);
            uint2 o;
            o.x = pack2(bflo(mo.x) + bflo(gb.x) * acc[ai][bj][m][n][0], bfhi(mo.x) + bfhi(gb.x) * acc[ai][bj][m][n][1]);
            o.y = pack2(bflo(mo.y) + bflo(gb.y) * acc[ai][bj][m][n][2], bfhi(mo.y) + bfhi(gb.y) * acc[ai][bj][m][n][3]);
            *(uint2*)(M + token * 1024 + f) = o;
          }
      }
  }
};
__device__ void phase4(const Params& p, unsigned char* smem) {
  TileSched S; S.init(4, 4 * 130);
  {
    pg8::Gemm g; g.A = (const u16*)(p.ws + OFF_QA); g.Bt = (const u16*)(p.ws + OFF_WOA); g.K = 512;
    EpiGateA E; E.ws = p.ws;
    pg8::gemm_phase((PG8_LAS unsigned char*)smem, g, S, E);
  }
  {
    pg8::Gemm g; g.A = (const u16*)(p.ws + OFF_QB); g.Bt = (const u16*)(p.ws + OFF_WOB); g.K = 512;
    EpiGateB E; E.ws = p.ws;
    pg8::gemm_phase((PG8_LAS unsigned char*)smem, g, S, E);
  }
}

struct EpiX1 {
  const Params& p;
  __device__ __forceinline__ void operator()(const acc8_t& acc, const pg8::Unit& u, int wr, int wc, int fr, int fq) const {
    u16* X1B = (u16*)(p.ws + OFF_X1B);
    float* rss = (float*)(p.ws + OFF_ROWSS);
#pragma unroll
    for (int ai = 0; ai < 2; ai++)
#pragma unroll
      for (int m = 0; m < 4; m++) {
        const int token = (int)EPI_TOKEN(u, ai, m);
        const float* xr = xrow(p, token);
        float ss = 0.f;
#pragma unroll
        for (int bj = 0; bj < 2; bj++)
#pragma unroll
          for (int n = 0; n < 2; n++) {
            const int f = EPI_COL(u, bj, n);
            const float4 xv = *(const float4*)(xr + f);
            const float4 o = make_float4(xv.x + acc[ai][bj][m][n][0], xv.y + acc[ai][bj][m][n][1], xv.z + acc[ai][bj][m][n][2], xv.w + acc[ai][bj][m][n][3]);
            ss += o.x * o.x + o.y * o.y + o.z * o.z + o.w * o.w;
            *(float4*)(p.out + O_Y + (size_t)token * 1024 + f) = o;
            uint2 ob; ob.x = pack2(o.x, o.y); ob.y = pack2(o.z, o.w);
            *(uint2*)(X1B + (size_t)token * 1024 + f) = ob;
          }
        ss = xsum16(ss);
        ss = xsum32(ss);
        if (fq == 0) atomicAdd(rss + token, ss);
      }
  }
};
__device__ void phase5(const Params& p, unsigned char* smem) {
  TileSched S; S.init(4, 4 * 130);
  pg8::Gemm g; g.A = (const u16*)(p.ws + OFF_M); g.Bt = (const u16*)(p.ws + OFF_WOUT); g.K = 1024;
  EpiX1 E{p};
  pg8::gemm_phase((PG8_LAS unsigned char*)smem, g, S, E);
}

struct EpiH {
  unsigned char* ws;
  __device__ __forceinline__ void operator()(const acc8_t& acc, const pg8::Unit& u, int wr, int wc, int fr, int fq) const {
    u16* H = (u16*)(ws + OFF_H);
    const float* rss = (const float*)(ws + OFF_ROWSS);
#pragma unroll
    for (int ai = 0; ai < 2; ai++)
#pragma unroll
      for (int m = 0; m < 4; m++) {
        const size_t token = EPI_TOKEN(u, ai, m);
        const float rs = rsqrtf(rss[token] * (1.f / 1024.f) + 1e-6f);
#pragma unroll
        for (int bj = 0; bj < 2; bj++)
#pragma unroll
          for (int n = 0; n < 2; n++) {
            const int f = EPI_COL(u, bj, n);
            const float v0 = fmaxf(acc[ai][bj][m][n][0] * rs, 0.f), v1 = fmaxf(acc[ai][bj][m][n][1] * rs, 0.f);
            const float v2 = fmaxf(acc[ai][bj][m][n][2] * rs, 0.f), v3 = fmaxf(acc[ai][bj][m][n][3] * rs, 0.f);
            uint2 o; o.x = pack2(v0 * v0, v1 * v1); o.y = pack2(v2 * v2, v3 * v3);
            *(uint2*)(H + token * 4096 + f) = o;
          }
      }
  }
};
__device__ void phase6(const Params& p, unsigned char* smem) {
  TileSched S; S.init(16, 16 * 130);
  pg8::Gemm g; g.A = (const u16*)(p.ws + OFF_X1B); g.Bt = (const u16*)(p.ws + OFF_WUP); g.K = 1024;
  EpiH E; E.ws = p.ws;
  pg8::gemm_phase((PG8_LAS unsigned char*)smem, g, S, E);
}

struct EpiY {
  float* out;
  __device__ __forceinline__ void operator()(const acc8_t& acc, const pg8::Unit& u, int wr, int wc, int fr, int fq) const {
#pragma unroll
    for (int ai = 0; ai < 2; ai++)
#pragma unroll
      for (int m = 0; m < 4; m++) {
        const size_t token = EPI_TOKEN(u, ai, m);
#pragma unroll
        for (int bj = 0; bj < 2; bj++)
#pragma unroll
          for (int n = 0; n < 2; n++) {
            float* yp = out + O_Y + token * 1024 + EPI_COL(u, bj, n);
            float4 y = *(const float4*)yp;
            y.x += acc[ai][bj][m][n][0]; y.y += acc[ai][bj][m][n][1]; y.z += acc[ai][bj][m][n][2]; y.w += acc[ai][bj][m][n][3];
            *(float4*)yp = y;
          }
      }
  }
};

constexpr size_t OFF_PART = OFF_XN;
__device__ void phase7(const Params& p, unsigned char* smem) {
  GemmSmem& sm = *(GemmSmem*)smem;
  unsigned char* ws = p.ws;
  const int tid = threadIdx.x, lane = tid & 63, wave = tid >> 6;
  const int r = lane & 31, h = lane >> 5;
  {
    TileSched S; S.init(4, 4 * 128);
    pg8::Gemm g; g.A = (const u16*)(ws + OFF_H); g.Bt = (const u16*)(ws + OFF_WDN); g.K = 4096;
    EpiY E; E.out = p.out;
    pg8::gemm_phase((PG8_LAS unsigned char*)smem, g, S, E);
  }
  for (int s = blockIdx.x; s < 128; s += gridDim.x) {
    const int tile = s >> 3, ks = s & 7;
    const int ft = tile & 7, tt = 128 + (tile >> 3);
    f32x16 acc[2][2];
    zero_acc(acc);
    gemm_kloop<512>((const u16*)(ws + OFF_WDN) + (size_t)ft * 128 * 4096 + ks * 512, 4096, (const u16*)(ws + OFF_H) + (size_t)tt * 256 * 4096 + ks * 512, 4096, acc, sm, tid);
    float* part = (float*)(ws + OFF_PART) + (size_t)s * 256 * 128;
#pragma unroll
    for (int tn = 0; tn < 2; tn++) {
      const int tl = (wave >> 1) * 64 + tn * 32 + r;
#pragma unroll
      for (int fm = 0; fm < 2; fm++)
#pragma unroll
        for (int q4 = 0; q4 < 4; q4++) {
          const int fl = (wave & 1) * 64 + fm * 32 + q4 * 8 + 4 * h;
          *(float4*)(part + (size_t)tl * 128 + fl) = make_float4(acc[fm][tn][q4 * 4 + 0], acc[fm][tn][q4 * 4 + 1], acc[fm][tn][q4 * 4 + 2], acc[fm][tn][q4 * 4 + 3]);
        }
    }
  }
}

__device__ void phase8(const Params& p, unsigned char* smem) {
  unsigned char* ws = p.ws;
  const float* part = (const float*)(ws + OFF_PART);
  const int gtid = blockIdx.x * blockDim.x + threadIdx.x, gsz = gridDim.x * blockDim.x;
  for (int i = gtid; i < 16 * 256 * 32; i += gsz) {
    const int f4 = i & 31, tl = (i >> 5) & 255, tile = i >> 13;
    const int ft = tile & 7, tt = 128 + (tile >> 3);
    float* yp = p.out + O_Y + (size_t)(tt * 256 + tl) * 1024 + ft * 128 + f4 * 4;
    float4 y = *(const float4*)yp;
#pragma unroll
    for (int ks = 0; ks < 8; ks++) {
      const float4 v = *(const float4*)(part + ((size_t)(tile * 8 + ks) * 256 + tl) * 128 + f4 * 4);
      y.x += v.x; y.y += v.y; y.z += v.z; y.w += v.w;
    }
    *(float4*)yp = y;
  }
}

__global__ void __launch_bounds__(512) mega(Params p, int ph_lo, int ph_hi) {
  __shared__ __align__(16) unsigned char smem[SMEM_BYTES];
#ifndef PROBE_DUP
#define PROBE_DUP -1
#endif
#ifndef PROBE_KLOOP
#define PROBE_KLOOP 0
#endif
#define RUN_PHASE(k, fn)                                  \
  if (ph_lo <= k && k <= ph_hi) {                         \
    if (k == PROBE_DUP) { fn(p, smem); cg::this_grid().sync(); } \
    fn(p, smem);                                          \
    if (k < ph_hi) cg::this_grid().sync();                \
  }
  RUN_PHASE(0, phase0)
  RUN_PHASE(1, phase1)
#if PROBE_REP2
  if (ph_lo <= 2 && 2 <= ph_hi) { for (int rep = 0; rep < PROBE_REP2; rep++) { phase2(p, smem); cg::this_grid().sync(); } }
#else
  RUN_PHASE(2, phase2)
#endif
#if PROBE_DRY3
  if (ph_lo <= 3 && 3 <= ph_hi) { phase3(p, smem, true); cg::this_grid().sync(); }
#endif
  RUN_PHASE(3, phase3)
  RUN_PHASE(4, phase4)
  RUN_PHASE(5, phase5)
  RUN_PHASE(6, phase6)
  RUN_PHASE(7, phase7)
  RUN_PHASE(8, phase8)
}

extern "C" void kernel_launch(void* const* d_in, const int* in_sizes, int n_in, void* d_out, int out_size,
                              void* d_ws, size_t ws_size, hipStream_t stream) {
  Params p{};
  for (int i = 0; i < 21; i++) p.in[i] = (const float*)d_in[i];
  p.out = (float*)d_out;
  p.ws = (unsigned char*)d_ws;
  static int grid_blocks = 0;
  if (!grid_blocks) {
    int dev = 0, cus = 0, per_cu = 0;
    hipGetDevice(&dev);
    hipDeviceGetAttribute(&cus, hipDeviceAttributeMultiprocessorCount, dev);
    hipOccupancyMaxActiveBlocksPerMultiprocessor(&per_cu, mega, 512, 0);
    if (per_cu < 1) per_cu = 1;
    grid_blocks = cus * per_cu;
  }
#if MULTI_LAUNCH
  for (int ph = 0; ph < 9; ph++) {
    hipLaunchKernelGGL(mega, dim3(grid_blocks), dim3(512), 0, stream, p, ph, ph);
  }
#else
  int lo = 0, hi = 8;
  void* args[] = {&p, &lo, &hi};
  hipError_t e = hipLaunchCooperativeKernel((void*)mega, dim3(grid_blocks), dim3(512), args, 0, stream);
  if (e != hipSuccess) fprintf(stderr, "cooperative launch failed: %s (grid %d)\n", hipGetErrorString(e), grid_blocks);
#endif
}
```

```cpp
#include <hip/hip_runtime.h>
#include <hip/hip_cooperative_groups.h>
#include <stdint.h>
#include <cstdio>
namespace cg = cooperative_groups;

typedef __attribute__((ext_vector_type(8))) short bf16x8;
typedef __attribute__((ext_vector_type(16))) float f32x16;
typedef __attribute__((ext_vector_type(4))) float f32x4;
typedef unsigned short u16;
typedef unsigned long long u64;

#ifndef PROBE_KLOOP
#define PROBE_KLOOP 0
#endif
#ifndef PROBE_REP2
#define PROBE_REP2 0
#endif
#ifndef PROBE_DRY3
#define PROBE_DRY3 0
#endif
#ifndef MULTI_LAUNCH
#define MULTI_LAUNCH 0
#endif

#define NTOK 33280
#define NPROMPT 32768
#define DM 1024
#define DFF 4096
#define NIN 5888
#define LOG2E 1.4426950408889634f

constexpr size_t AL(size_t x) { return (x + 255) & ~(size_t)255; }
constexpr size_t OFF_WIN = 0;
constexpr size_t OFF_WOA = OFF_WIN + AL((size_t)NIN * 1024 * 2);
constexpr size_t OFF_WOB = OFF_WOA + AL((size_t)1024 * 512 * 2);
constexpr size_t OFF_WOUT = OFF_WOB + AL((size_t)1024 * 512 * 2);
constexpr size_t OFF_WUP = OFF_WOUT + AL((size_t)1024 * 1024 * 2);
constexpr size_t OFF_WDN = OFF_WUP + AL((size_t)4096 * 1024 * 2);
constexpr size_t OFF_CS = OFF_WDN + AL((size_t)4096 * 1024 * 2);
constexpr size_t OFF_ROWSS = OFF_CS + AL((size_t)8192 * 8 * 8);
constexpr size_t OFF_XN = OFF_ROWSS + AL((size_t)NTOK * 4);
constexpr size_t OFF_MASKP = OFF_XN;
constexpr size_t OFF_MASKS = OFF_MASKP + (size_t)NPROMPT * 128 * 8;
constexpr size_t OFF_X1B = OFF_XN;
constexpr size_t OFF_Z = OFF_XN + AL((size_t)NTOK * 1024 * 2);
constexpr size_t OFF_QA = OFF_Z;
constexpr size_t OFF_QB = OFF_QA + AL((size_t)NTOK * 512 * 2);
constexpr size_t OFF_QI = OFF_QB + AL((size_t)NTOK * 512 * 2);
constexpr size_t OFF_GA = OFF_QI + AL((size_t)NTOK * 512 * 2);
constexpr size_t OFF_GB = OFF_GA + AL((size_t)NTOK * 1024 * 2);
constexpr size_t OFF_WI = OFF_GB + AL((size_t)NTOK * 1024 * 2);
constexpr size_t OFF_KAP = OFF_WI + AL((size_t)NTOK * 8 * 4);
constexpr size_t OFF_KAS = OFF_KAP + AL((size_t)4 * 8 * 8192 * 64 * 2);
constexpr size_t OFF_VAP = OFF_KAS + AL((size_t)8 * 8 * 1088 * 64 * 2);
constexpr size_t OFF_VAS = OFF_VAP + AL((size_t)4 * 8 * 8192 * 64 * 2);
constexpr size_t OFF_KIP = OFF_VAS + AL((size_t)8 * 8 * 1088 * 64 * 2);
constexpr size_t OFF_KIS = OFF_KIP + AL((size_t)4 * 8192 * 64 * 2);
constexpr size_t OFF_KBP = OFF_KIS + AL((size_t)8 * 1088 * 64 * 2);
constexpr size_t OFF_KBS = OFF_KBP + AL((size_t)4 * 8 * 8192 * 64 * 2);
constexpr size_t OFF_VBP = OFF_KBS + AL((size_t)8 * 8 * 576 * 64 * 2);
constexpr size_t OFF_VBS = OFF_VBP + AL((size_t)4 * 8 * 8192 * 64 * 2);
constexpr size_t OFF_END = OFF_VBS + AL((size_t)8 * 8 * 576 * 64 * 2);
constexpr size_t OFF_M = OFF_KAP;
constexpr size_t OFF_H = OFF_Z;
static_assert(OFF_MASKS + (size_t)512 * 32 * 8 <= OFF_Z, "mask overlay");
static_assert(OFF_M + (size_t)NTOK * 1024 * 2 <= OFF_END, "M overlay");
static_assert(OFF_H + (size_t)NTOK * 4096 * 2 <= OFF_END, "H overlay");
static_assert(OFF_END <= (size_t)512 * 1024 * 1024, "ws budget");

constexpr size_t O_Y = 0;
constexpr size_t O_KAP = (size_t)NTOK * 1024;
constexpr size_t O_VAP = O_KAP + (size_t)4 * 8192 * 512;
constexpr size_t O_KIP = O_VAP + (size_t)4 * 8192 * 512;
constexpr size_t O_KBP = O_KIP + (size_t)4 * 8192 * 64;
constexpr size_t O_VBP = O_KBP + (size_t)4 * 512 * 512;
constexpr size_t O_KAS = O_VBP + (size_t)4 * 512 * 512;
constexpr size_t O_VAS = O_KAS + (size_t)8 * 64 * 512;
constexpr size_t O_KIS = O_VAS + (size_t)8 * 64 * 512;
constexpr size_t O_KBS = O_KIS + (size_t)8 * 64 * 64;
constexpr size_t O_VBS = O_KBS + (size_t)8 * 64 * 512;

struct Params {
  const float* in[21];
  float* out;
  unsigned char* ws;
};

__device__ __forceinline__ u16 f2bf(float f) {
  uint32_t u = __float_as_uint(f);
  u += 0x7FFFu + ((u >> 16) & 1u);
  return (u16)(u >> 16);
}
typedef __bf16 bf16v2 __attribute__((ext_vector_type(2)));
typedef float f32v2 __attribute__((ext_vector_type(2)));
__device__ __forceinline__ uint32_t pack2(float a, float b) {
  f32v2 v = {a, b};
  bf16v2 r = __builtin_convertvector(v, bf16v2);
  return __builtin_bit_cast(uint32_t, r);
}
__device__ __forceinline__ float bf2f(u16 v) { return __uint_as_float(((uint32_t)v) << 16); }
__device__ __forceinline__ float bflo(uint32_t v) { return __uint_as_float(v << 16); }
__device__ __forceinline__ float bfhi(uint32_t v) { return __uint_as_float(v & 0xFFFF0000u); }
__device__ __forceinline__ f32x16 mfma32(bf16x8 a, bf16x8 b, f32x16 c) {
  return __builtin_amdgcn_mfma_f32_32x32x16_bf16(a, b, c, 0, 0, 0);
}
__device__ __forceinline__ f32x4 mfma16(bf16x8 a, bf16x8 b, f32x4 c) {
  return __builtin_amdgcn_mfma_f32_16x16x32_bf16(a, b, c, 0, 0, 0);
}
__device__ __forceinline__ bf16x8 as_bf8(uint4 v) {
  union { uint4 u; bf16x8 b; } x; x.u = v; return x.b;
}
__device__ __forceinline__ const float* xrow(const Params& p, int token) {
  return token < NPROMPT ? p.in[0] + (size_t)token * 1024 : p.in[1] + (size_t)(token - NPROMPT) * 1024;
}

__device__ __forceinline__ float xsum16(float v) {
  auto r = __builtin_amdgcn_permlane16_swap(__float_as_uint(v), __float_as_uint(v), false, false);
  return __uint_as_float(r[0]) + __uint_as_float(r[1]);
}
__device__ __forceinline__ float xsum32(float v) {
  auto r = __builtin_amdgcn_permlane32_swap(__float_as_uint(v), __float_as_uint(v), false, false);
  return __uint_as_float(r[0]) + __uint_as_float(r[1]);
}
__device__ __forceinline__ float xother32(float v, bool lower_half) {
  auto r = __builtin_amdgcn_permlane32_swap(__float_as_uint(v), __float_as_uint(v), false, false);
  return lower_half ? __uint_as_float(r[1]) : __uint_as_float(r[0]);
}

#define SMEM_BYTES (131072 + 8192)

struct GemmSmem { u16 A[2][128][72]; u16 B[2][256][72]; };

#define GEMM_MMA(cb, kk)                                                               \
  {                                                                                    \
    bf16x8 a0_ = *(const bf16x8*)&sm.A[cb][wf * 64 + r][(kk) * 16 + h * 8];            \
    bf16x8 a1_ = *(const bf16x8*)&sm.A[cb][wf * 64 + 32 + r][(kk) * 16 + h * 8];       \
    bf16x8 b0_ = *(const bf16x8*)&sm.B[cb][wt * 64 + r][(kk) * 16 + h * 8];            \
    bf16x8 b1_ = *(const bf16x8*)&sm.B[cb][wt * 64 + 32 + r][(kk) * 16 + h * 8];       \
    acc[0][0] = mfma32(a0_, b0_, acc[0][0]);                                           \
    acc[0][1] = mfma32(a0_, b1_, acc[0][1]);                                           \
    acc[1][0] = mfma32(a1_, b0_, acc[1][0]);                                           \
    acc[1][1] = mfma32(a1_, b1_, acc[1][1]);                                           \
  }
#define GEMM_STEP(cb, A0, A1, B0, B1, B2, B3, dowrite, doload, tload)                  \
  {                                                                                    \
    GEMM_MMA(cb, 0)                                                                    \
    if (dowrite) { *(uint4*)&sm.A[cb ^ 1][crow][ccol] = A0; *(uint4*)&sm.A[cb ^ 1][crow + 64][ccol] = A1; } \
    __builtin_amdgcn_sched_barrier(0);                                                 \
    GEMM_MMA(cb, 1)                                                                    \
    if (dowrite) { *(uint4*)&sm.B[cb ^ 1][crow][ccol] = B0; *(uint4*)&sm.B[cb ^ 1][crow + 64][ccol] = B1; } \
    __builtin_amdgcn_sched_barrier(0);                                                 \
    GEMM_MMA(cb, 2)                                                                    \
    if (dowrite) { *(uint4*)&sm.B[cb ^ 1][crow + 128][ccol] = B2; *(uint4*)&sm.B[cb ^ 1][crow + 192][ccol] = B3; } \
    __builtin_amdgcn_sched_barrier(0);                                                 \
    GEMM_MMA(cb, 3)                                                                    \
    if (doload) {                                                                      \
      const u16* ap_ = ap + (size_t)(tload) * 64; const u16* bp_ = bp + (size_t)(tload) * 64; \
      A0 = *(const uint4*)(ap_); A1 = *(const uint4*)(ap_ + as64);                     \
      B0 = *(const uint4*)(bp_); B1 = *(const uint4*)(bp_ + bs64); B2 = *(const uint4*)(bp_ + 2 * bs64); B3 = *(const uint4*)(bp_ + 3 * bs64); \
    }                                                                                  \
    __syncthreads();                                                                   \
  }

template <int KTOT>
__device__ __forceinline__ void gemm_kloop(const u16* __restrict__ Ag, int lda, const u16* __restrict__ Bg, int ldb,
                                           f32x16 (&acc)[2][2], GemmSmem& sm, int tid) {
  const int lane = tid & 63, wave = tid >> 6;
  const int wf = wave & 1, wt = wave >> 1;
  const int r = lane & 31, h = lane >> 5;
  constexpr int KT = KTOT / 64;
  const int crow = tid >> 3, ccol = (tid & 7) * 8;
  const u16* ap = Ag + (size_t)crow * lda + ccol;
  const u16* bp = Bg + (size_t)crow * ldb + ccol;
  const size_t as64 = (size_t)64 * lda, bs64 = (size_t)64 * ldb;
  uint4 ra0 = *(const uint4*)(ap), ra1 = *(const uint4*)(ap + as64);
  uint4 rb0 = *(const uint4*)(bp), rb1 = *(const uint4*)(bp + bs64), rb2 = *(const uint4*)(bp + 2 * bs64), rb3 = *(const uint4*)(bp + 3 * bs64);
  *(uint4*)&sm.A[0][crow][ccol] = ra0;
  *(uint4*)&sm.A[0][crow + 64][ccol] = ra1;
  *(uint4*)&sm.B[0][crow][ccol] = rb0;
  *(uint4*)&sm.B[0][crow + 64][ccol] = rb1;
  *(uint4*)&sm.B[0][crow + 128][ccol] = rb2;
  *(uint4*)&sm.B[0][crow + 192][ccol] = rb3;
  ra0 = *(const uint4*)(ap + 64); ra1 = *(const uint4*)(ap + 64 + as64);
  rb0 = *(const uint4*)(bp + 64); rb1 = *(const uint4*)(bp + 64 + bs64); rb2 = *(const uint4*)(bp + 64 + 2 * bs64); rb3 = *(const uint4*)(bp + 64 + 3 * bs64);
  __syncthreads();
  for (int kt = 0; kt < KT; kt += 2) {
    GEMM_STEP(0, ra0, ra1, rb0, rb1, rb2, rb3, true, (kt + 2 < KT), kt + 2)
    GEMM_STEP(1, ra0, ra1, rb0, rb1, rb2, rb3, (kt + 2 < KT), (kt + 3 < KT), kt + 3)
  }
}

__device__ __forceinline__ void tile_range(int N, int& lo, int& hi, int& step) {
  if ((gridDim.x & 7) == 0) {
    const int x = blockIdx.x & 7, l = blockIdx.x >> 3;
    lo = (int)((long long)x * N / 8) + l; hi = (int)((long long)(x + 1) * N / 8); step = gridDim.x >> 3;
  } else { lo = blockIdx.x; hi = N; step = gridDim.x; }
}
__device__ __forceinline__ void tile_decode(int i, int NF, int& ft, int& tt) {
  const int full = 128 * NF;
  if (i < full) { const int g = i / (4 * NF); const int rem = i - g * 4 * NF; ft = rem >> 2; tt = 4 * g + (rem & 3); }
  else { const int rem = i - full; ft = rem >> 1; tt = 128 + (rem & 1); }
}

__device__ __forceinline__ void zero_acc(f32x16 (&acc)[2][2]) {
#pragma unroll
  for (int a = 0; a < 2; a++)
#pragma unroll
    for (int b = 0; b < 2; b++)
#pragma unroll
      for (int i = 0; i < 16; i++) acc[a][b][i] = 0.f;
}

namespace pg8 {
#define PG8_LAS __attribute__((address_space(3)))
constexpr int BM = 256, BK = 64, HALF = 128, HTB = HALF * BK * 2, STAGE_BYTES = 8 * HTB;
__device__ __forceinline__ int lds_byte(int r, int c) { const int st = (r >> 4) * 2 + (c >> 5), rr = r & 15, cc = c & 31, ob = rr * 64 + cc * 2; return st * 1024 + (ob ^ (((ob >> 9) & 1) << 5)); }
__device__ __forceinline__ void stage_rc(int b, int& R, int& C) { const int st = b / 1024, sb = b % 1024, swz = sb ^ (((sb >> 9) & 1) << 5); R = (st >> 1) * 16 + swz / 64; C = (st & 1) * 32 + (swz % 64) / 2; }
struct Unit { int pm, pn; };
struct Gemm { const u16* A; const u16* Bt; int K; };

template <class Epi, class Sched>
__device__ __forceinline__ void gemm_phase(PG8_LAS unsigned char* lds, const Gemm g, const Sched& S, const Epi& E) {
    const int tid = threadIdx.x, wid = __builtin_amdgcn_readfirstlane(tid >> 6), lane = tid & 63, wr = wid >> 2, wc = wid & 3, fr = lane & 15, fq = lane >> 4;
    const int K = g.K, nt = K / BK;
    unsigned voffA[2], voffB[2];
#pragma unroll
    for (int i = 0; i < 2; ++i) { int R, C; stage_rc(tid * 16 + i * 8192, R, C); voffA[i] = (unsigned)(R * K + C) * 2u; voffB[i] = voffA[i]; }
    const size_t kstep = (size_t)(BK * 2);
    const size_t hstep = (size_t)HALF * K * 2;
    const size_t tstep = 2 * hstep;
    const unsigned ldsw = (unsigned)wid * 1024u;
    const int aoff = lds_byte(wr * 64 + fr, fq * 8), boff = lds_byte(wc * 32 + fr, fq * 8);
#define PG8_SA(b, h) (((b) * 2 + (h)) * HTB)
#define PG8_SB(b, h) ((4 + (b) * 2 + (h)) * HTB)
#define PG8_STAGE(bufoff, gbase, voff) do { _Pragma("unroll") for (int _i = 0; _i < 2; ++_i) \
        __builtin_amdgcn_global_load_lds((const unsigned*)((const char*)(gbase) + (voff)[_i]), (PG8_LAS unsigned*)(lds + (bufoff) + ldsw + _i * 8192), 16, 0, 0); } while (0)
#define PG8_LDA(dst, b, h) do { _Pragma("unroll") for (int m = 0; m < 4; ++m) _Pragma("unroll") for (int k = 0; k < 2; ++k) dst[m][k] = *(const PG8_LAS bf16x8*)(lds + PG8_SA(b, h) + aoff + m * 2048 + k * 1024); } while (0)
#define PG8_LDB(dst, b, h) do { _Pragma("unroll") for (int n = 0; n < 2; ++n) _Pragma("unroll") for (int k = 0; k < 2; ++k) dst[n][k] = *(const PG8_LAS bf16x8*)(lds + PG8_SB(b, h) + boff + n * 2048 + k * 1024); } while (0)
#define PG8_MMA(ai, bj, At, Bt) do { __builtin_amdgcn_s_setprio(1); _Pragma("unroll") for (int m = 0; m < 4; ++m) _Pragma("unroll") for (int n = 0; n < 2; ++n) _Pragma("unroll") for (int k = 0; k < 2; ++k) \
        acc[ai][bj][m][n] = __builtin_amdgcn_mfma_f32_16x16x32_bf16(Bt[n][k], At[m][k], acc[ai][bj][m][n], 0, 0, 0); __builtin_amdgcn_s_setprio(0); } while (0)
#define PG8_WAIT_V(n) asm volatile("s_waitcnt vmcnt(" #n ")" ::: "memory")
#define PG8_WAIT_L(n) asm volatile("s_waitcnt lgkmcnt(" #n ")" ::: "memory")
#define PG8_BAR __builtin_amdgcn_s_barrier()
#define PG8_SCHED __builtin_amdgcn_sched_barrier(0)
    Unit cur, nxt; int ui = 0;
    if (!S.next(0, cur)) return;
    f32x4 acc[2][2][4][2];
#pragma unroll
    for (int a = 0; a < 2; ++a)
#pragma unroll
        for (int b = 0; b < 2; ++b)
#pragma unroll
            for (int m = 0; m < 4; ++m)
#pragma unroll
                for (int n = 0; n < 2; ++n) acc[a][b][m][n] = (f32x4){0.f, 0.f, 0.f, 0.f};
    bf16x8 At[4][2], B0[2][2], B1[2][2];
    const char* cA = (const char*)g.A + (size_t)cur.pm * tstep; const char* cB = (const char*)g.Bt + (size_t)cur.pn * tstep;
    PG8_STAGE(PG8_SB(0, 0), cB, voffB); PG8_STAGE(PG8_SA(0, 0), cA, voffA); PG8_STAGE(PG8_SB(0, 1), cB + hstep, voffB); PG8_STAGE(PG8_SA(0, 1), cA + hstep, voffA);
    if (wr == 1) PG8_BAR;
    PG8_WAIT_V(4); PG8_BAR;
    PG8_STAGE(PG8_SB(1, 0), cB + kstep, voffB); PG8_STAGE(PG8_SA(1, 0), cA + kstep, voffA); PG8_STAGE(PG8_SB(1, 1), cB + hstep + kstep, voffB);
    PG8_WAIT_V(6); PG8_BAR;
    for (;;) {
        const bool has_next = S.next(ui + 1, nxt);
        const char* nA = has_next ? (const char*)g.A + (size_t)nxt.pm * tstep : cA; const char* nB = has_next ? (const char*)g.Bt + (size_t)nxt.pn * tstep : cB;
        for (int t = 0; t < nt; t += 2) {
            const bool last = (t == nt - 2);
            const char* a1 = cA + (size_t)(t + 1) * kstep;
            const char* a2 = last ? nA : cA + (size_t)(t + 2) * kstep; const char* b2 = last ? nB : cB + (size_t)(t + 2) * kstep;
            const char* a3 = a2 + kstep; const char* b3 = b2 + kstep;
            PG8_LDB(B0, 0, 0); PG8_SCHED; PG8_LDA(At, 0, 0); PG8_STAGE(PG8_SA(1, 1), a1 + hstep, voffA);
            PG8_WAIT_L(8); PG8_BAR; PG8_WAIT_L(0); PG8_MMA(0, 0, At, B0); PG8_BAR; PG8_SCHED;
            PG8_LDB(B1, 0, 1); PG8_STAGE(PG8_SB(0, 0), b2, voffB);
            PG8_BAR; PG8_WAIT_L(0); PG8_MMA(0, 1, At, B1); PG8_BAR;
            PG8_LDA(At, 0, 1); PG8_STAGE(PG8_SA(0, 0), a2, voffA);
            PG8_BAR; PG8_WAIT_L(0); PG8_MMA(1, 0, At, B0); PG8_BAR; PG8_SCHED;
            PG8_STAGE(PG8_SB(0, 1), b2 + hstep, voffB);
            PG8_WAIT_V(6); PG8_BAR; PG8_MMA(1, 1, At, B1); PG8_BAR;
            PG8_LDB(B0, 1, 0); PG8_SCHED; PG8_LDA(At, 1, 0); PG8_STAGE(PG8_SA(0, 1), a2 + hstep, voffA);
            PG8_WAIT_L(8); PG8_BAR; PG8_WAIT_L(0); PG8_MMA(0, 0, At, B0); PG8_BAR; PG8_SCHED;
            PG8_LDB(B1, 1, 1); PG8_STAGE(PG8_SB(1, 0), b3, voffB);
            PG8_BAR; PG8_WAIT_L(0); PG8_MMA(0, 1, At, B1); PG8_BAR;
            PG8_LDA(At, 1, 1); PG8_STAGE(PG8_SA(1, 0), a3, voffA);
            PG8_BAR; PG8_WAIT_L(0); PG8_MMA(1, 0, At, B0); PG8_BAR; PG8_SCHED;
            PG8_STAGE(PG8_SB(1, 1), b3 + hstep, voffB);
            PG8_WAIT_V(6); PG8_BAR; PG8_MMA(1, 1, At, B1); PG8_BAR;
        }
        E(acc, cur, wr, wc, fr, fq);
        if (!has_next) break;
#pragma unroll
        for (int a = 0; a < 2; ++a)
#pragma unroll
            for (int b = 0; b < 2; ++b)
#pragma unroll
                for (int m = 0; m < 4; ++m)
#pragma unroll
                    for (int n = 0; n < 2; ++n) acc[a][b][m][n] = (f32x4){0.f, 0.f, 0.f, 0.f};
        cur = nxt; cA = nA; cB = nB; ++ui;
    }
    PG8_WAIT_V(0);
    if (wr == 0) PG8_BAR;
    PG8_BAR;
#undef PG8_SA
#undef PG8_SB
#undef PG8_STAGE
#undef PG8_LDA
#undef PG8_LDB
#undef PG8_MMA
#undef PG8_WAIT_V
#undef PG8_WAIT_L
#undef PG8_BAR
#undef PG8_SCHED
}
}

struct TileSched {
  int NF, lo, hi, step;
  __device__ __forceinline__ void init(int nf, int ntiles) { NF = nf; tile_range(ntiles, lo, hi, step); }
  __device__ __forceinline__ bool next(int i, pg8::Unit& u) const {
    const int t = lo + i * step;
    if (t >= hi) return false;
    int ft, tt; tile_decode(t, NF, ft, tt); u.pm = tt; u.pn = ft; return true;
  }
};
typedef f32x4 acc8_t[2][2][4][2];

__device__ void tconv_tile(const float* __restrict__ src, int ldsrc, int k0, int nsrc0, int nvalid,
                           u16* __restrict__ dst, int K, int ndst0, const float* __restrict__ gain, float* sm, int tid, int permg = -1) {
  const int nl = tid & 63, kl0 = tid >> 6;
#pragma unroll
  for (int i = 0; i < 8; i++) {
    int kl = kl0 + 8 * i;
    float v = 0.f;
    if (nl < nvalid) {
      v = src[(size_t)(k0 + kl) * ldsrc + nsrc0 + nl];
      if (gain) v *= gain[k0 + kl];
    }
    sm[kl * 65 + nl] = v;
  }
  __syncthreads();
  const int kl = tid & 63, nl0 = tid >> 6;
#pragma unroll
  for (int i = 0; i < 8; i++) {
    int n = nl0 + 8 * i;
    const int drow = permg >= 0 ? 256 * (permg >> 2) + 128 * (n >> 5) + 32 * (permg & 3) + (n & 31) : ndst0 + n;
    dst[(size_t)drow * K + k0 + kl] = f2bf(sm[kl * 65 + n]);
  }
  __syncthreads();
}

__device__ __forceinline__ void tconv_wave(const float* __restrict__ src, int ldsrc, int k0, int nsrc0, int nvalid,
                                           u16* __restrict__ dst, int K, int ndst0, const float* __restrict__ gain, float* smw, int lane, int permg) {
#pragma unroll 1
  for (int kb = 0; kb < 64; kb += 32) {
    float v[32];
#pragma unroll
    for (int i = 0; i < 32; i++) {
      float t = 0.f;
      if (lane < nvalid) {
        t = src[(size_t)(k0 + kb + i) * ldsrc + nsrc0 + lane];
        if (gain) t *= gain[k0 + kb + i];
      }
      v[i] = t;
    }
#pragma unroll
    for (int i = 0; i < 32; i++) smw[(kb + i) * 65 + lane] = v[i];
  }
#pragma unroll 8
  for (int n = 0; n < 64; n++) {
    const int drow = permg >= 0 ? 256 * (permg >> 2) + 128 * (n >> 5) + 32 * (permg & 3) + (n & 31) : ndst0 + n;
    dst[(size_t)drow * K + k0 + lane] = f2bf(smw[lane * 65 + n]);
  }
}

__device__ __forceinline__ int inproj_src_col(int g) {
  if (g < 33) return g * 64;
  if (g < 89) return 2120 + (g - 33) * 64;
  return 2112;
}

__device__ void phase0(const Params& p, unsigned char* smem) {
  const int tid = threadIdx.x;
  unsigned char* ws = p.ws;
  float* smf = (float*)smem;
  const int NT_IN = 92 * 16, NT_OA = 16 * 8, NT_OUT = 16 * 16, NT_UP = 64 * 16, NT_DN = 16 * 64;
  const int total = NT_IN + 2 * NT_OA + NT_OUT + NT_UP + NT_DN;
  {
    const int lane_ = tid & 63, wave_ = tid >> 6;
    float* smw = smf + wave_ * (64 * 65);
    for (int t = blockIdx.x * 8 + wave_; t < total; t += gridDim.x * 8) {
      int u = t;
      const float* src; int ld, k0, nsrc0, nvalid = 64, K, ndst0, permg = -1; u16* dst; const float* gain = nullptr;
      if (u < NT_IN) {
        const int g = u / 16, kb = u % 16;
        src = p.in[8]; ld = 5704; k0 = kb * 64; nsrc0 = inproj_src_col(g); nvalid = g >= 90 ? 0 : (g == 89 ? 8 : 64);
        dst = (u16*)(ws + OFF_WIN); K = 1024; ndst0 = g * 64; permg = g;
      } else if ((u -= NT_IN) < NT_OA) {
        const int g = u / 8, kb = u % 8; src = p.in[15]; ld = 1024; k0 = kb * 64; nsrc0 = g * 64; dst = (u16*)(ws + OFF_WOA); K = 512; ndst0 = g * 64;
      } else if ((u -= NT_OA) < NT_OA) {
        const int g = u / 8, kb = u % 8; src = p.in[16]; ld = 1024; k0 = kb * 64; nsrc0 = g * 64; dst = (u16*)(ws + OFF_WOB); K = 512; ndst0 = g * 64;
      } else if ((u -= NT_OA) < NT_OUT) {
        const int g = u / 16, kb = u % 16; src = p.in[17]; ld = 1024; k0 = kb * 64; nsrc0 = g * 64; dst = (u16*)(ws + OFF_WOUT); K = 1024; ndst0 = g * 64;
      } else if ((u -= NT_OUT) < NT_UP) {
        const int g = u / 16, kb = u % 16; src = p.in[19]; ld = 4096; k0 = kb * 64; nsrc0 = g * 64; dst = (u16*)(ws + OFF_WUP); K = 1024; ndst0 = g * 64; gain = p.in[18];
      } else {
        u -= NT_UP;
        const int g = u / 64, kb = u % 64; src = p.in[20]; ld = 1024; k0 = kb * 64; nsrc0 = g * 64; dst = (u16*)(ws + OFF_WDN); K = 4096; ndst0 = g * 64;
      }
      tconv_wave(src, ld, k0, nsrc0, nvalid, dst, K, ndst0, gain, smw, lane_, permg);
    }
  }
  {
    const int lane = tid & 63, wave = tid >> 6;
    const float* g = p.in[7];
    u16* XN = (u16*)(ws + OFF_XN);
    const int rstride = gridDim.x * 8;
    for (int row = blockIdx.x * 8 + wave; row < NTOK; row += 2 * rstride) {
      const int row2 = row + rstride;
      const bool has2 = row2 < NTOK;
      const float4* xr = (const float4*)xrow(p, row);
      const float4* xr2 = (const float4*)xrow(p, has2 ? row2 : row);
      float4 v[4], w[4];
      float ss = 0.f, ss2 = 0.f;
#pragma unroll
      for (int i = 0; i < 4; i++) { v[i] = xr[lane + 64 * i]; w[i] = xr2[lane + 64 * i]; }
#pragma unroll
      for (int i = 0; i < 4; i++) {
        ss += v[i].x * v[i].x + v[i].y * v[i].y + v[i].z * v[i].z + v[i].w * v[i].w;
        ss2 += w[i].x * w[i].x + w[i].y * w[i].y + w[i].z * w[i].z + w[i].w * w[i].w;
      }
#pragma unroll
      for (int o = 32; o >= 1; o >>= 1) { ss += __shfl_xor(ss, o); ss2 += __shfl_xor(ss2, o); }
      const float rs = rsqrtf(ss * (1.f / 1024.f) + 1e-6f), rs2 = rsqrtf(ss2 * (1.f / 1024.f) + 1e-6f);
#pragma unroll
      for (int i = 0; i < 4; i++) {
        const float4 gg = ((const float4*)g)[lane + 64 * i];
        uint2 o;
        o.x = pack2(v[i].x * rs * gg.x, v[i].y * rs * gg.y);
        o.y = pack2(v[i].z * rs * gg.z, v[i].w * rs * gg.w);
        *(uint2*)(XN + (size_t)row * 1024 + (lane + 64 * i) * 4) = o;
        if (has2) {
          uint2 o2;
          o2.x = pack2(w[i].x * rs2 * gg.x, w[i].y * rs2 * gg.y);
          o2.y = pack2(w[i].z * rs2 * gg.z, w[i].w * rs2 * gg.w);
          *(uint2*)(XN + (size_t)row2 * 1024 + (lane + 64 * i) * 4) = o2;
        }
      }
    }
  }
  const size_t gtid = (size_t)blockIdx.x * blockDim.x + tid;
  const size_t gsz = (size_t)gridDim.x * blockDim.x;
  {
    float2* CS = (float2*)(ws + OFF_CS);
    for (size_t i = gtid; i < 8192 * 8; i += gsz) {
      int pos = (int)(i >> 3), f = (int)(i & 7);
      float inv = powf(500000.0f, -(float)f / 8.0f);
      float ang = (float)pos * inv;
      double rr = (double)ang;
      rr = rr - 6.283185307179586 * rint(rr * 0.15915494309189535);
      float s, c;
      sincosf((float)rr, &s, &c);
      CS[i] = make_float2(c, s);
    }
    float* rss = (float*)(ws + OFF_ROWSS);
    for (size_t i = gtid; i < NTOK; i += gsz) rss[i] = 0.f;
  }
  {
    u16* KAS = (u16*)(ws + OFF_KAS); u16* VAS = (u16*)(ws + OFF_VAS); u16* KIS = (u16*)(ws + OFF_KIS);
    u16* KBS = (u16*)(ws + OFF_KBS); u16* VBS = (u16*)(ws + OFF_VBS);
    const float* cka = p.in[2]; const float* cva = p.in[3]; const float* cki = p.in[4];
    const float* ckb = p.in[5]; const float* cvb = p.in[6];
#pragma unroll 2
    for (size_t i4 = gtid; i4 < (size_t)8 * 1024 * 512 / 4; i4 += gsz) {
      const size_t i = i4 * 4;
      int d = (int)(i & 63), hd = (int)((i >> 6) & 7), j = (int)((i >> 9) & 1023), bs = (int)(i >> 19);
      const float4 kk4 = *(const float4*)(cka + i);
      const float4 vv4 = *(const float4*)(cva + i);
      uint2 ko; ko.x = pack2(kk4.x, kk4.y); ko.y = pack2(kk4.z, kk4.w);
      *(uint2*)(KAS + ((size_t)(bs * 8 + hd) * 1088 + j) * 64 + d) = ko;
      u16* vd = VAS + (size_t)(bs * 8 + hd) * 64 * 1088 + (size_t)(j >> 6) * 4096 + d * 64 + (j & 63);
      vd[0] = f2bf(vv4.x); vd[64] = f2bf(vv4.y); vd[2 * 64] = f2bf(vv4.z); vd[3 * 64] = f2bf(vv4.w);
    }
    for (size_t i4 = gtid; i4 < (size_t)8 * 1024 * 64 / 4; i4 += gsz) {
      const size_t i = i4 * 4;
      int d = (int)(i & 63), j = (int)((i >> 6) & 1023), bs = (int)(i >> 16);
      const float4 kk4 = *(const float4*)(cki + i);
      uint2 ko; ko.x = pack2(kk4.x, kk4.y); ko.y = pack2(kk4.z, kk4.w);
      *(uint2*)(KIS + ((size_t)bs * 1088 + j) * 64 + d) = ko;
    }
#pragma unroll 2
    for (size_t i4 = gtid; i4 < (size_t)8 * 512 * 512 / 4; i4 += gsz) {
      const size_t i = i4 * 4;
      int d = (int)(i & 63), hd = (int)((i >> 6) & 7), j = (int)((i >> 9) & 511), bs = (int)(i >> 18);
      const float4 kk4 = *(const float4*)(ckb + i);
      const float4 vv4 = *(const float4*)(cvb + i);
      uint2 ko; ko.x = pack2(kk4.x, kk4.y); ko.y = pack2(kk4.z, kk4.w);
      *(uint2*)(KBS + ((size_t)(bs * 8 + hd) * 576 + j) * 64 + d) = ko;
      u16* vd = VBS + (size_t)(bs * 8 + hd) * 64 * 576 + (size_t)(j >> 6) * 4096 + d * 64 + (j & 63);
      vd[0] = f2bf(vv4.x); vd[64] = f2bf(vv4.y); vd[2 * 64] = f2bf(vv4.z); vd[3 * 64] = f2bf(vv4.w);
    }
  }
}

template <int AI>
__device__ __forceinline__ void epi_inproj(const Params& p, const acc8_t& acc, int g, int tbase, int fr, int fq) {
  unsigned char* ws = p.ws;
  const bool sample = tbase >= NPROMPT;
  int b, trow;
  if (!sample) { b = tbase >> 13; trow = tbase & 8191; } else { b = (tbase - NPROMPT) >> 6; trow = 0; }
  const float* gain = nullptr; bool rope = false, sig = false;
  u16* bdst = nullptr; size_t brow0 = 0; int bld = 0, bcol = 0;
  u16* vdst = nullptr; int vS = 0, vcol0 = 0;
  float* fdst = nullptr; size_t frow0 = 0; int fld = 0, fcol = 0;
  bool wi = false;
  if (g < 8) { gain = p.in[9]; rope = true; bdst = (u16*)(ws + OFF_QA); brow0 = tbase; bld = 512; bcol = g * 64; }
  else if (g < 16) {
    int hd = g - 8; gain = p.in[10]; rope = true; bld = 64;
    if (!sample) { bdst = (u16*)(ws + OFF_KAP) + (size_t)(b * 8 + hd) * 8192 * 64; brow0 = trow; fdst = p.out + O_KAP; frow0 = tbase; }
    else { bdst = (u16*)(ws + OFF_KAS) + (size_t)(b * 8 + hd) * 1088 * 64; brow0 = 1024; fdst = p.out + O_KAS; frow0 = b * 64; }
    fld = 512; fcol = hd * 64;
  } else if (g < 24) {
    int hd = g - 16;
    if (!sample) { vdst = (u16*)(ws + OFF_VAP) + (size_t)(b * 8 + hd) * 64 * 8192; vS = 8192; vcol0 = trow; fdst = p.out + O_VAP; frow0 = tbase; }
    else { vdst = (u16*)(ws + OFF_VAS) + (size_t)(b * 8 + hd) * 64 * 1088; vS = 1088; vcol0 = 1024; fdst = p.out + O_VAS; frow0 = b * 64; }
    fld = 512; fcol = hd * 64;
  } else if (g < 32) { rope = true; bdst = (u16*)(ws + OFF_QI); brow0 = tbase; bld = 512; bcol = (g - 24) * 64; }
  else if (g == 32) {
    gain = p.in[11]; rope = true; bld = 64; fld = 64;
    if (!sample) { bdst = (u16*)(ws + OFF_KIP) + (size_t)b * 8192 * 64; brow0 = trow; fdst = p.out + O_KIP; frow0 = tbase; }
    else { bdst = (u16*)(ws + OFF_KIS) + (size_t)b * 1088 * 64; brow0 = 1024; fdst = p.out + O_KIS; frow0 = b * 64; }
  } else if (g < 41) { gain = p.in[12]; bdst = (u16*)(ws + OFF_QB); brow0 = tbase; bld = 512; bcol = (g - 33) * 64; }
  else if (g < 49) {
    int hd = g - 41; gain = p.in[13]; bld = 64; fld = 512; fcol = hd * 64;
    if (!sample) {
      bdst = (u16*)(ws + OFF_KBP) + (size_t)(b * 8 + hd) * 8192 * 64; brow0 = trow;
      if (trow >= 7680) { fdst = p.out + O_KBP; frow0 = b * 512 + (trow - 7680); }
    } else { bdst = (u16*)(ws + OFF_KBS) + (size_t)(b * 8 + hd) * 576 * 64; brow0 = 512; fdst = p.out + O_KBS; frow0 = b * 64; }
  } else if (g < 57) {
    int hd = g - 49; fld = 512; fcol = hd * 64;
    if (!sample) {
      vdst = (u16*)(ws + OFF_VBP) + (size_t)(b * 8 + hd) * 64 * 8192; vS = 8192; vcol0 = trow;
      if (trow >= 7680) { fdst = p.out + O_VBP; frow0 = b * 512 + (trow - 7680); }
    } else { vdst = (u16*)(ws + OFF_VBS) + (size_t)(b * 8 + hd) * 64 * 576; vS = 576; vcol0 = 512; fdst = p.out + O_VBS; frow0 = b * 64; }
  } else if (g < 73) { sig = true; bdst = (u16*)(ws + OFF_GA); brow0 = tbase; bld = 1024; bcol = (g - 57) * 64; }
  else if (g < 89) { sig = true; bdst = (u16*)(ws + OFF_GB); brow0 = tbase; bld = 1024; bcol = (g - 73) * 64; }
  else wi = true;

  float4 gg[2][2];
  if (gain) {
#pragma unroll
    for (int bj = 0; bj < 2; bj++)
#pragma unroll
      for (int n = 0; n < 2; n++) gg[bj][n] = *(const float4*)(gain + 32 * bj + 16 * n + 4 * fq);
  }
#pragma unroll
  for (int m = 0; m < 4; m++) {
    const int tl = 16 * m + fr;
    float x[16];
#pragma unroll
    for (int bj = 0; bj < 2; bj++)
#pragma unroll
      for (int n = 0; n < 2; n++)
#pragma unroll
        for (int j = 0; j < 4; j++) x[(bj * 2 + n) * 4 + j] = acc[AI][bj][m][n][j];
    if (wi) {
      if (fq < 2) *(float4*)((float*)(ws + OFF_WI) + (size_t)(tbase + tl) * 8 + 4 * fq) = make_float4(x[0], x[1], x[2], x[3]);
      continue;
    }
    if (gain) {
      float ss = 0.f;
#pragma unroll
      for (int k = 0; k < 16; k++) ss += x[k] * x[k];
      ss = xsum16(ss);
      ss = xsum32(ss);
      const float rs = rsqrtf(ss * (1.f / 64.f) + 1e-6f);
#pragma unroll
      for (int bj = 0; bj < 2; bj++)
#pragma unroll
        for (int n = 0; n < 2; n++) {
          x[(bj * 2 + n) * 4 + 0] *= rs * gg[bj][n].x; x[(bj * 2 + n) * 4 + 1] *= rs * gg[bj][n].y;
          x[(bj * 2 + n) * 4 + 2] *= rs * gg[bj][n].z; x[(bj * 2 + n) * 4 + 3] *= rs * gg[bj][n].w;
        }
    }
    if (rope) {
      const int pos = sample ? 1024 + tl : trow + tl;
      const float4* cs = (const float4*)((const float2*)(ws + OFF_CS) + (size_t)pos * 8 + 4 * (fq & 1));
      const float4 c01 = cs[0], c23 = cs[1];
      const float cc[4] = {c01.x, c01.z, c23.x, c23.z};
      const float sn[4] = {c01.y, c01.w, c23.y, c23.w};
#pragma unroll
      for (int j = 0; j < 4; j++) {
        const float other = xother32(x[j], fq < 2);
        x[j] = (fq < 2) ? x[j] * cc[j] - other * sn[j] : x[j] * cc[j] + other * sn[j];
      }
    }
    if (sig) {
#pragma unroll
      for (int k = 0; k < 16; k++) x[k] = __builtin_amdgcn_rcpf(1.f + __builtin_amdgcn_exp2f(-LOG2E * x[k]));
    }
    if (bdst) {
      u16* d = bdst + (brow0 + tl) * (size_t)bld + bcol;
#pragma unroll
      for (int bj = 0; bj < 2; bj++)
#pragma unroll
        for (int n = 0; n < 2; n++) {
          uint2 o;
          o.x = pack2(x[(bj * 2 + n) * 4 + 0], x[(bj * 2 + n) * 4 + 1]);
          o.y = pack2(x[(bj * 2 + n) * 4 + 2], x[(bj * 2 + n) * 4 + 3]);
          *(uint2*)(d + 32 * bj + 16 * n + 4 * fq) = o;
        }
    }
    if (vdst) {
      const int q = fr & 3;
      const bool q1 = (q & 1) != 0, q2 = (q & 2) != 0;
#define DPPX(v, ctrl) __int_as_float(__builtin_amdgcn_update_dpp(0, __float_as_int(v), ctrl, 0xf, 0xf, true))
#pragma unroll
      for (int bj = 0; bj < 2; bj++)
#pragma unroll
        for (int n = 0; n < 2; n++) {
          float r0 = x[(bj * 2 + n) * 4 + 0], r1 = x[(bj * 2 + n) * 4 + 1], r2 = x[(bj * 2 + n) * 4 + 2], r3 = x[(bj * 2 + n) * 4 + 3];
          { const float s01 = q1 ? r0 : r1, g01 = DPPX(s01, 0xB1); if (q1) r0 = g01; else r1 = g01;
            const float s23 = q1 ? r2 : r3, g23 = DPPX(s23, 0xB1); if (q1) r2 = g23; else r3 = g23; }
          { const float s02 = q2 ? r0 : r2, g02 = DPPX(s02, 0x4E); if (q2) r0 = g02; else r2 = g02;
            const float s13 = q2 ? r1 : r3, g13 = DPPX(s13, 0x4E); if (q2) r1 = g13; else r3 = g13; }
          const int f = 32 * bj + 16 * n + 4 * fq + q;
          uint2 o; o.x = pack2(r0, r1); o.y = pack2(r2, r3);
          *(uint2*)(vdst + (size_t)(vcol0 >> 6) * 4096 + f * 64 + 16 * m + 4 * (fr >> 2)) = o;
        }
#undef DPPX
    }
    if (fdst) {
      float* d = fdst + (frow0 + tl) * (size_t)fld + fcol;
#pragma unroll
      for (int bj = 0; bj < 2; bj++)
#pragma unroll
        for (int n = 0; n < 2; n++)
          { f32x4 v_ = {x[(bj * 2 + n) * 4 + 0], x[(bj * 2 + n) * 4 + 1], x[(bj * 2 + n) * 4 + 2], x[(bj * 2 + n) * 4 + 3]};
            __builtin_nontemporal_store(v_, (f32x4*)(d + 32 * bj + 16 * n + 4 * fq)); }
    }
  }
}

struct EpiInproj {
  const Params& p;
  __device__ __forceinline__ void operator()(const acc8_t& acc, const pg8::Unit& u, int wr, int wc, int fr, int fq) const {
    const int g = u.pn * 4 + wc;
    if (g >= 90) return;
    int fr_ = fr, fq_ = fq;
    asm volatile("" : "+v"(fr_), "+v"(fq_));
    epi_inproj<0>(p, acc, g, u.pm * 256 + 64 * wr, fr_, fq_);
    asm volatile("" : "+v"(fr_), "+v"(fq_));
    epi_inproj<1>(p, acc, g, u.pm * 256 + 128 + 64 * wr, fr_, fq_);
  }
};

__device__ void phase1(const Params& p, unsigned char* smem) {
  TileSched S; S.init(23, 23 * 130);
  pg8::Gemm g; g.A = (const u16*)(p.ws + OFF_XN); g.Bt = (const u16*)(p.ws + OFF_WIN); g.K = 1024;
  EpiInproj E{p};
  pg8::gemm_phase(( PG8_LAS unsigned char*)smem, g, S, E);
}

#define P2_LOADCHUNK(c, A0, B0, A1, B1, A2, B2, A3, B3)                          \
  {                                                                              \
    const u16* kr_ = kbase + (size_t)(c) * 4096;                                 \
    A0 = as_bf8(*(const uint4*)(kr_));        B0 = as_bf8(*(const uint4*)(kr_ + 32));        \
    A1 = as_bf8(*(const uint4*)(kr_ + 1024)); B1 = as_bf8(*(const uint4*)(kr_ + 1024 + 32)); \
    A2 = as_bf8(*(const uint4*)(kr_ + 2048)); B2 = as_bf8(*(const uint4*)(kr_ + 2048 + 32)); \
    A3 = as_bf8(*(const uint4*)(kr_ + 3072)); B3 = as_bf8(*(const uint4*)(kr_ + 3072 + 32)); \
  }
#define P2_SCORE(K0, K1, kg)                                                     \
  {                                                                              \
    _Pragma("unroll") for (int pp = 0; pp < 4; pp++) {                           \
      f32x4 a_ = {0.f, 0.f, 0.f, 0.f};                                           \
      a_ = mfma16(qa[pp][0], K0, a_);                                            \
      a_ = mfma16(qa[pp][1], K1, a_);                                            \
      float s_ = wv[pp].x * fmaxf(a_[0], 0.f) + wv[pp].y * fmaxf(a_[1], 0.f) + wv[pp].z * fmaxf(a_[2], 0.f) + wv[pp].w * fmaxf(a_[3], 0.f); \
      { auto r_ = __builtin_amdgcn_permlane16_swap(__float_as_uint(s_), __float_as_uint(s_), false, false); \
        s_ = __uint_as_float(r_[0]) + __uint_as_float(r_[1]); }                  \
      if ((g4 & 1) == 0) {                                                       \
        _Float16 hv_ = (_Float16)s_;                                             \
        u16 bits_ = __builtin_bit_cast(u16, hv_);                                \
        bits_ ^= (bits_ & 0x8000) ? (u16)0xFFFF : (u16)0x8000;                   \
        sc[2 * pp + (g4 >> 1)][(kg) * 16 + n16] = bits_;                         \
      }                                                                          \
    }                                                                            \
  }
#define P2_COUNT(mh_, cnt_)                                                      \
  {                                                                              \
    uint32_t c_ = 0;                                                             \
    _Pragma("unroll") for (int j = 0; j < 16; j++) if (j < nv512) {              \
      c_ += (v[j].x >= mh_) + ((v[j].x << 16) >= mh_);                           \
      c_ += (v[j].y >= mh_) + ((v[j].y << 16) >= mh_);                           \
      c_ += (v[j].z >= mh_) + ((v[j].z << 16) >= mh_);                           \
      c_ += (v[j].w >= mh_) + ((v[j].w << 16) >= mh_);                           \
    }                                                                            \
    _Pragma("unroll") for (int o_ = 32; o_ >= 1; o_ >>= 1) c_ += __shfl_xor(c_, o_); \
    cnt_ = (int)c_;                                                              \
  }

__device__ void phase2(const Params& p, unsigned char* smem) {
  u16 (*sc)[8192] = (u16 (*)[8192])smem;
  unsigned char* ws = p.ws;
  const int tid = threadIdx.x, lane = tid & 63, wave = tid >> 6;
  const int NTILE = 4096 + 64;
  for (int it = blockIdx.x; it < NTILE; it += gridDim.x) {
    const int rr = it >> 8, ww = it & 255;
    const int idx = (rr & 1) ? (rr << 8) + 255 - ww : it;
    int tok0, nvis; const u16* KI; u64* mrow0; int mld;
    if (idx < 4096) {
      int b = idx & 3, j8 = 1023 - (idx >> 2);
      int q0 = j8 * 8;
      tok0 = b * 8192 + q0; nvis = ((q0 >> 6) + 1) * 64;
      KI = (const u16*)(ws + OFF_KIP) + (size_t)b * 8192 * 64;
      mrow0 = (u64*)(ws + OFF_MASKP) + (size_t)tok0 * 128; mld = 128;
    } else {
      int s = idx - 4096; int b = s >> 3, q0 = (s & 7) * 8;
      tok0 = NPROMPT + b * 64 + q0; nvis = 1088;
      KI = (const u16*)(ws + OFF_KIS) + (size_t)b * 1088 * 64;
      mrow0 = (u64*)(ws + OFF_MASKS) + (size_t)(b * 64 + q0) * 32; mld = 32;
    }
    const int nv512 = (nvis + 511) >> 9;
    {
      const int tail = nv512 * 512 - nvis;
      for (int e = tid; e < 8 * tail; e += 512) { int q = e / tail, k = e % tail; sc[q][nvis + k] = 0; }
    }
    const u16* QI = (const u16*)(ws + OFF_QI);
    const float* WI = (const float*)(ws + OFF_WI);
    const int n16 = lane & 15, g4 = lane >> 4;
    bf16x8 qa[4][2]; float4 wv[4];
#pragma unroll
    for (int pp = 0; pp < 4; pp++) {
      const int ql = 2 * pp + (n16 >> 3), hh = n16 & 7;
#pragma unroll
      for (int kh = 0; kh < 2; kh++)
        qa[pp][kh] = as_bf8(*(const uint4*)(QI + (size_t)(tok0 + ql) * 512 + hh * 64 + kh * 32 + 8 * g4));
      wv[pp] = *(const float4*)(WI + (size_t)(tok0 + 2 * pp + (g4 >> 1)) * 8 + 4 * (g4 & 1));
    }
    {
      const int nchunk = nvis >> 6;
      const u16* kbase = KI + (size_t)n16 * 64 + 8 * g4;
      bf16x8 nA0, nB0, nA1, nB1, nA2, nB2, nA3, nB3;
      int c = wave;
      if (c < nchunk) P2_LOADCHUNK(c, nA0, nB0, nA1, nB1, nA2, nB2, nA3, nB3)
      for (; c < nchunk; c += 8) {
        bf16x8 cA0 = nA0, cB0 = nB0, cA1 = nA1, cB1 = nB1, cA2 = nA2, cB2 = nB2, cA3 = nA3, cB3 = nB3;
        if (c + 8 < nchunk) P2_LOADCHUNK(c + 8, nA0, nB0, nA1, nB1, nA2, nB2, nA3, nB3)
        __builtin_amdgcn_sched_barrier(0);
        P2_SCORE(cA0, cB0, c * 4 + 0)
        P2_SCORE(cA1, cB1, c * 4 + 1)
        P2_SCORE(cA2, cB2, c * 4 + 2)
        P2_SCORE(cA3, cB3, c * 4 + 3)
      }
    }
    __syncthreads();
    {
      const u16* my = sc[wave];
      uint32_t T = 0, need_eq = 0;
      if (nvis > 256) {
        uint32_t* hist = (uint32_t*)(smem + 131072) + wave * 256;
        uint32_t Bsel = 0, above = 0;
#pragma unroll
        for (int pass = 0; pass < 2; pass++) {
          *(uint4*)(hist + lane * 4) = make_uint4(0u, 0u, 0u, 0u);
          __builtin_amdgcn_fence(__ATOMIC_RELEASE, "wavefront");
          {
            uint4 cur = *(const uint4*)(my + lane * 8);
            for (int j = 0; j < nv512; j++) {
              uint4 nxt = cur;
              if (j + 1 < nv512) nxt = *(const uint4*)(my + ((j + 1) * 64 + lane) * 8);
#pragma unroll
              for (int e = 0; e < 8; e++) {
                const uint32_t w = (e >> 1) == 0 ? cur.x : ((e >> 1) == 1 ? cur.y : ((e >> 1) == 2 ? cur.z : cur.w));
                const uint32_t k = (e & 1) ? (w >> 16) : (w & 0xFFFFu);
                if (pass == 0) atomicAdd(hist + (k >> 8), 1u);
                else if ((k >> 8) == Bsel) atomicAdd(hist + (k & 255u), 1u);
              }
              cur = nxt;
            }
          }
          __builtin_amdgcn_fence(__ATOMIC_ACQ_REL, "wavefront");
          uint4 hh; { const volatile uint32_t* hv_ = hist + lane * 4; hh.x = hv_[0]; hh.y = hv_[1]; hh.z = hv_[2]; hh.w = hv_[3]; }
          const uint32_t target = 256u - above;
          const uint32_t ssum = hh.x + hh.y + hh.z + hh.w;
          uint32_t suf = ssum;
#pragma unroll
          for (int o = 1; o < 64; o <<= 1) { uint32_t t = __shfl_down(suf, o); if (lane + o < 64) suf += t; }
          const uint32_t excl = suf - ssum;
          const bool hit = (excl < target) && (suf >= target);
          uint32_t bl = 0, ab = 0;
          {
            const uint32_t c3 = excl + hh.w, c2 = c3 + hh.z, c1 = c2 + hh.y;
            if (c3 >= target) { bl = 3; ab = excl; }
            else if (c2 >= target) { bl = 2; ab = c3; }
            else if (c1 >= target) { bl = 1; ab = c2; }
            else { bl = 0; ab = c1; }
          }
          const u64 hb = __ballot(hit);
          const int src = hb ? (int)__builtin_ctzll(hb) : 0;
          const uint32_t binsel = (uint32_t)__shfl((int)(lane * 4 + bl), src);
          const uint32_t absel = (uint32_t)__shfl((int)ab, src);
          if (pass == 0) { Bsel = binsel; above = absel; }
          else { T = (Bsel << 8) | binsel; need_eq = 256u - (above + absel); }
        }
      }
      u64* mrow = mrow0 + (size_t)wave * mld;
      uint32_t eq_seen = 0;
      const u64 ltmask = (1ull << lane) - 1ull;
      uint4 cur = *(const uint4*)(my + lane * 8);
      for (int j = 0; j < nv512; j++) {
        uint4 nxt = cur;
        if (j + 1 < nv512) nxt = *(const uint4*)(my + ((j + 1) * 64 + lane) * 8);
        u64 myword = 0;
#pragma unroll
        for (int e = 0; e < 8; e++) {
          const uint32_t w = (e >> 1) == 0 ? cur.x : ((e >> 1) == 1 ? cur.y : ((e >> 1) == 2 ? cur.z : cur.w));
          const uint32_t k = (e & 1) ? (w >> 16) : (w & 0xFFFFu);
          const bool gt = k > T, eq = (k == T);
          const u64 beq = __ballot(eq);
          const uint32_t rank = __popcll(beq & ltmask);
          const bool sel = gt || (eq && (eq_seen + rank) < need_eq);
          const u64 m = __ballot(sel);
          eq_seen += __popcll(beq);
          if (lane == e) myword = m;
        }
        if (lane < 8) mrow[j * 8 + lane] = myword;
        cur = nxt;
      }
    }
    __syncthreads();
  }
}

struct AttnSmem { u16 K[2][64][72]; u16 VT[2][64][72]; float bias[264]; };

__device__ __forceinline__ void attn_tile(const bool BAND, AttnSmem& sm, u16* Qg, int qtok0, int hd, int nw, const u16* __restrict__ Kg,
                          const u16* __restrict__ VTg, int S, int qloc0, const u64* maskrow0, int mld,
                          const float* bias_tab, int tid, const bool dry = false) {
  const int lane = tid & 63, wave = tid >> 6;
  const int r = lane & 31, h = lane >> 5;
  const bool wact = wave < nw;
  const int wq0 = qloc0 + 32 * wave;
  const int cw = wq0 >> 6;
  const int c_first = qloc0 >> 6, c_last = (qloc0 + 32 * (nw - 1)) >> 6;
  const int kt_lo = BAND ? (c_first - 8 > 0 ? c_first - 8 : 0) : 0;
  if (BAND) {
    for (int e = tid; e < 257; e += 512) sm.bias[e] = bias_tab[e * 8 + hd] * LOG2E;
  }
  bf16x8 qf0, qf1, qf2, qf3;
  u16* qrow = Qg + (size_t)(qtok0 + 32 * wave + r) * 512 + hd * 64;
  const float csc = 0.125f * LOG2E;
  if (wact) {
#define LOADQ(dst, kk)                                                              \
    { uint4 t_ = *(const uint4*)(qrow + (kk) * 16 + h * 8);                          \
      t_.x = pack2(bflo(t_.x) * csc, bfhi(t_.x) * csc); t_.y = pack2(bflo(t_.y) * csc, bfhi(t_.y) * csc); \
      t_.z = pack2(bflo(t_.z) * csc, bfhi(t_.z) * csc); t_.w = pack2(bflo(t_.w) * csc, bfhi(t_.w) * csc); \
      dst = as_bf8(t_); }
    LOADQ(qf0, 0) LOADQ(qf1, 1) LOADQ(qf2, 2) LOADQ(qf3, 3)
#undef LOADQ
  }
  const bool usemask = !BAND && wact;
  const u64* mrow = usemask ? maskrow0 + (size_t)(32 * wave + r) * mld + 4 * h : nullptr;
  u64 mw0 = 0, mw1 = 0, mw2 = 0, mw3 = 0, nx0 = 0, nx1 = 0, nx2 = 0, nx3 = 0;
  if (usemask) { nx0 = mrow[0]; nx1 = mrow[1]; nx2 = mrow[2]; nx3 = mrow[3]; }
  f32x16 o0, o1;
#pragma unroll
  for (int i = 0; i < 16; i++) { o0[i] = 0.f; o1[i] = 0.f; }
  float lsum = 0.f;
  const int lrow = tid >> 3, lcol = (tid & 7) * 8;
  const u16* kptr = Kg + (size_t)(kt_lo * 64 + lrow) * 64 + lcol;
  const u16* vptr = VTg + (size_t)kt_lo * 4096 + lrow * 64 + lcol;
  uint4 kv = *(const uint4*)kptr;
  uint4 vv = *(const uint4*)vptr;
  *(uint4*)&sm.K[0][lrow][lcol] = kv;
  *(uint4*)&sm.VT[0][lrow][lcol] = vv;
  if (kt_lo < c_last) {
    kptr += 64 * 64; vptr += 4096;
    kv = *(const uint4*)kptr;
    vv = *(const uint4*)vptr;
  }
  __syncthreads();
  for (int kt = kt_lo; kt <= c_last; kt++) {
    const int cur = (kt - kt_lo) & 1;
    if (kt < c_last) {
      *(uint4*)&sm.K[cur ^ 1][lrow][lcol] = kv;
      *(uint4*)&sm.VT[cur ^ 1][lrow][lcol] = vv;
      if (kt + 1 < c_last) {
        kptr += 64 * 64; vptr += 4096;
        kv = *(const uint4*)kptr;
        vv = *(const uint4*)vptr;
      }
    }
    if (usemask) {
      if ((kt & 7) == 0) { mw0 = nx0; mw1 = nx1; mw2 = nx2; mw3 = nx3; }
      if ((kt & 7) == 1 && kt + 7 <= cw) {
        const u64* mn = mrow + ((kt >> 3) + 1) * 8;
        nx0 = mn[0]; nx1 = mn[1]; nx2 = mn[2]; nx3 = mn[3];
      }
    }
    __builtin_amdgcn_sched_barrier(0);
    const bool act = wact && kt <= cw && (!BAND || kt >= cw - 8);
    if (act) {
      const int bsh = (kt & 7) * 8;
      uint32_t mb[4];
      mb[0] = (uint32_t)(mw0 >> bsh) & 0xFFu; mb[1] = (uint32_t)(mw1 >> bsh) & 0xFFu;
      mb[2] = (uint32_t)(mw2 >> bsh) & 0xFFu; mb[3] = (uint32_t)(mw3 >> bsh) & 0xFFu;
#pragma unroll
      for (int sb = 0; sb < 2; sb++) {
        f32x16 s;
#pragma unroll
        for (int i = 0; i < 16; i++) s[i] = 0.f;
        s = mfma32(*(const bf16x8*)&sm.K[cur][sb * 32 + r][0 * 16 + h * 8], qf0, s);
        s = mfma32(*(const bf16x8*)&sm.K[cur][sb * 32 + r][1 * 16 + h * 8], qf1, s);
        s = mfma32(*(const bf16x8*)&sm.K[cur][sb * 32 + r][2 * 16 + h * 8], qf2, s);
        s = mfma32(*(const bf16x8*)&sm.K[cur][sb * 32 + r][3 * 16 + h * 8], qf3, s);
        float pv[16];
        if (BAND) {
          const int qpos = wq0 + r;
          if (kt <= cw - 3) {
            const float bb = sm.bias[256];
#pragma unroll
            for (int i = 0; i < 16; i++) pv[i] = __builtin_amdgcn_exp2f(s[i] + bb);
          } else {
#pragma unroll
            for (int i = 0; i < 16; i++) {
              int kpos = kt * 64 + sb * 32 + (i & 3) + 8 * (i >> 2) + 4 * h;
              int dd = qpos - kpos;
              dd = dd < -128 ? -128 : (dd > 128 ? 128 : dd);
              pv[i] = __builtin_amdgcn_exp2f(s[i] + sm.bias[dd + 128]);
            }
          }
        } else {
#pragma unroll
          for (int i = 0; i < 16; i++) {
            const int bit = sb * 4 + (i >> 2);
            const float e = __builtin_amdgcn_exp2f(s[i]);
            int m;
            asm("v_bfe_i32 %0, %1, %2, 1" : "=v"(m) : "v"(mb[i & 3]), "s"(bit));
            pv[i] = __uint_as_float(__float_as_uint(e) & (uint32_t)m);
          }
        }
#pragma unroll
        for (int i = 0; i < 16; i++) lsum += pv[i];
#pragma unroll
        for (int st = 0; st < 2; st++) {
          union { uint32_t u[4]; bf16x8 b; } pf;
#pragma unroll
          for (int j = 0; j < 4; j++) pf.u[j] = pack2(pv[8 * st + 2 * j], pv[8 * st + 2 * j + 1]);
          union { uint2 u[2]; bf16x8 b; } v0, v1;
          const int kc = sb * 32 + 16 * st + 4 * h;
          v0.u[0] = *(const uint2*)&sm.VT[cur][r][kc];
          v0.u[1] = *(const uint2*)&sm.VT[cur][r][kc + 8];
          v1.u[0] = *(const uint2*)&sm.VT[cur][32 + r][kc];
          v1.u[1] = *(const uint2*)&sm.VT[cur][32 + r][kc + 8];
          o0 = mfma32(v0.b, pf.b, o0);
          o1 = mfma32(v1.b, pf.b, o1);
        }
      }
    }
    __syncthreads();
  }
  if (wact && (!dry || lsum == 12345.678f)) {
    lsum += __shfl_xor(lsum, 32);
    const float inv = 1.f / lsum;
#pragma unroll
    for (int q4 = 0; q4 < 4; q4++) {
      uint2 a, b;
      a.x = pack2(o0[q4 * 4 + 0] * inv, o0[q4 * 4 + 1] * inv);
      a.y = pack2(o0[q4 * 4 + 2] * inv, o0[q4 * 4 + 3] * inv);
      b.x = pack2(o1[q4 * 4 + 0] * inv, o1[q4 * 4 + 1] * inv);
      b.y = pack2(o1[q4 * 4 + 2] * inv, o1[q4 * 4 + 3] * inv);
      *(uint2*)(qrow + q4 * 8 + 4 * h) = a;
      *(uint2*)(qrow + 32 + q4 * 8 + 4 * h) = b;
    }
  }
  __syncthreads();
}

__device__ void phase3(const Params& p, unsigned char* smem, const bool dry = false) {
  AttnSmem& sm = *(AttnSmem*)smem;
  unsigned char* ws = p.ws;
  const int tid = threadIdx.x;
  const int NITEM = 1024 + 1024 + 64 + 64;
  for (int it = blockIdx.x; it < NITEM; it += gridDim.x) {
    bool band; int qtok0, hd, nw, S, qloc0, mld = 0; u16* Qg; const u16* Kg; const u16* VTg; const u64* mrow0 = nullptr;
    if (it < 1024) {
      const int rr = it >> 8, ww = it & 255;
      const int w2 = (rr & 1) ? 255 - ww : ww;
      const int j = 31 - (rr * 8 + (w2 >> 5)), bh = w2 & 31;
      const int b = bh >> 3; hd = bh & 7;
      band = false; Qg = (u16*)(ws + OFF_QA); qtok0 = b * 8192 + j * 256; nw = 8; S = 8192; qloc0 = j * 256;
      Kg = (const u16*)(ws + OFF_KAP) + (size_t)(b * 8 + hd) * 8192 * 64;
      VTg = (const u16*)(ws + OFF_VAP) + (size_t)(b * 8 + hd) * 64 * 8192;
      mrow0 = (const u64*)(ws + OFF_MASKP) + (size_t)(b * 8192 + j * 256) * 128; mld = 128;
    } else if (it < 2048) {
      const int u = it - 1024;
      const int j = u >> 5, bh = u & 31;
      const int b = bh >> 3; hd = bh & 7;
      band = true; Qg = (u16*)(ws + OFF_QB); qtok0 = b * 8192 + j * 256; nw = 8; S = 8192; qloc0 = j * 256;
      Kg = (const u16*)(ws + OFF_KBP) + (size_t)(b * 8 + hd) * 8192 * 64;
      VTg = (const u16*)(ws + OFF_VBP) + (size_t)(b * 8 + hd) * 64 * 8192;
    } else if (it < 2048 + 64) {
      const int u = it - 2048;
      const int b = u >> 3; hd = u & 7;
      band = false; Qg = (u16*)(ws + OFF_QA); qtok0 = NPROMPT + b * 64; nw = 2; S = 1088; qloc0 = 1024;
      Kg = (const u16*)(ws + OFF_KAS) + (size_t)(b * 8 + hd) * 1088 * 64;
      VTg = (const u16*)(ws + OFF_VAS) + (size_t)(b * 8 + hd) * 64 * 1088;
      mrow0 = (const u64*)(ws + OFF_MASKS) + (size_t)(b * 64) * 32; mld = 32;
    } else {
      const int u = it - 2048 - 64;
      const int b = u >> 3; hd = u & 7;
      band = true; Qg = (u16*)(ws + OFF_QB); qtok0 = NPROMPT + b * 64; nw = 2; S = 576; qloc0 = 512;
      Kg = (const u16*)(ws + OFF_KBS) + (size_t)(b * 8 + hd) * 576 * 64;
      VTg = (const u16*)(ws + OFF_VBS) + (size_t)(b * 8 + hd) * 64 * 576;
    }
    attn_tile(band, sm, Qg, qtok0, hd, nw, Kg, VTg, S, qloc0, mrow0, mld, p.in[14], tid, dry);
  }
}

#define EPI_TOKEN(u, ai, m) ((size_t)((u).pm * 256 + 128 * (ai) + 64 * wr + 16 * (m) + fr))
#define EPI_COL(u, bj, n) ((u).pn * 256 + 128 * (bj) + 32 * wc + 16 * (n) + 4 * fq)

struct EpiGateA {
  unsigned char* ws;
  __device__ __forceinline__ void operator()(const acc8_t& acc, const pg8::Unit& u, int wr, int wc, int fr, int fq) const {
    const u16* GA = (const u16*)(ws + OFF_GA); u16* M = (u16*)(ws + OFF_M);
#pragma unroll
    for (int ai = 0; ai < 2; ai++)
#pragma unroll
      for (int m = 0; m < 4; m++) {
        const size_t token = EPI_TOKEN(u, ai, m);
#pragma unroll
        for (int bj = 0; bj < 2; bj++)
#pragma unroll
          for (int n = 0; n < 2; n++) {
            const int f = EPI_COL(u, bj, n);
            const uint2 ga = *(const uint2*)(GA + token * 1024 + f);
            uint2 o;
            o.x = pack2(bflo(ga.x) * acc[ai][bj][m][n][0], bfhi(ga.x) * acc[ai][bj][m][n][1]);
            o.y = pack2(bflo(ga.y) * acc[ai][bj][m][n][2], bfhi(ga.y) * acc[ai][bj][m][n][3]);
            *(uint2*)(M + token * 1024 + f) = o;
          }
      }
  }
};
struct EpiGateB {
  unsigned char* ws;
  __device__ __forceinline__ void operator()(const acc8_t& acc, const pg8::Unit& u, int wr, int wc, int fr, int fq) const {
    const u16* GB = (const u16*)(ws + OFF_GB); u16* M = (u16*)(ws + OFF_M);
#pragma unroll
    for (int ai = 0; ai < 2; ai++)
#pragma unroll
      for (int m = 0; m < 4; m++) {
        const size_t token = EPI_TOKEN(u, ai, m);
#pragma unroll
        for (int bj = 0; bj < 2; bj++)
#pragma unroll
          for (int n = 0; n < 2; n++) {
            const int f = EPI_COL(u, bj, n);
            const uint2 gb = *(const uint2*)(GB + token * 1024 + f);
            const uint2 mo = *(const uint2*)(M + token * 1024 + f);
            uint2 o;
            o.x = pack2(bflo(mo.x) + bflo(gb.x) * acc[ai][bj][m][n][0], bfhi(mo.x) + bfhi(gb.x) * acc[ai][bj][m][n][1]);
            o.y = pack2(bflo(mo.y) + bflo(gb.y) * acc[ai][bj][m][n][2], bfhi(mo.y) + bfhi(gb.y) * acc[ai][bj][m][n][3]);
            *(uint2*)(M + token * 1024 + f) = o;
          }
      }
  }
};
__device__ void phase4(const Params& p, unsigned char* smem) {
  TileSched S; S.init(4, 4 * 130);
  {
    pg8::Gemm g; g.A = (const u16*)(p.ws + OFF_QA); g.Bt = (const u16*)(p.ws + OFF_WOA); g.K = 512;
    EpiGateA E; E.ws = p.ws;
    pg8::gemm_phase((PG8_LAS unsigned char*)smem, g, S, E);
  }
  {
    pg8::Gemm g; g.A = (const u16*)(p.ws + OFF_QB); g.Bt = (const u16*)(p.ws + OFF_WOB); g.K = 512;
    EpiGateB E; E.ws = p.ws;
    pg8::gemm_phase((PG8_LAS unsigned char*)smem, g, S, E);
  }
}

struct EpiX1 {
  const Params& p;
  __device__ __forceinline__ void operator()(const acc8_t& acc, const pg8::Unit& u, int wr, int wc, int fr, int fq) const {
    u16* X1B = (u16*)(p.ws + OFF_X1B);
    float* rss = (float*)(p.ws + OFF_ROWSS);
#pragma unroll
    for (int ai = 0; ai < 2; ai++)
#pragma unroll
      for (int m = 0; m < 4; m++) {
        const int token = (int)EPI_TOKEN(u, ai, m);
        const float* xr = xrow(p, token);
        float ss = 0.f;
#pragma unroll
        for (int bj = 0; bj < 2; bj++)
#pragma unroll
          for (int n = 0; n < 2; n++) {
            const int f = EPI_COL(u, bj, n);
            const float4 xv = *(const float4*)(xr + f);
            const float4 o = make_float4(xv.x + acc[ai][bj][m][n][0], xv.y + acc[ai][bj][m][n][1], xv.z + acc[ai][bj][m][n][2], xv.w + acc[ai][bj][m][n][3]);
            ss += o.x * o.x + o.y * o.y + o.z * o.z + o.w * o.w;
            *(float4*)(p.out + O_Y + (size_t)token * 1024 + f) = o;
            uint2 ob; ob.x = pack2(o.x, o.y); ob.y = pack2(o.z, o.w);
            *(uint2*)(X1B + (size_t)token * 1024 + f) = ob;
          }
        ss = xsum16(ss);
        ss = xsum32(ss);
        if (fq == 0) atomicAdd(rss + token, ss);
      }
  }
};
__device__ void phase5(const Params& p, unsigned char* smem) {
  TileSched S; S.init(4, 4 * 130);
  pg8::Gemm g; g.A = (const u16*)(p.ws + OFF_M); g.Bt = (const u16*)(p.ws + OFF_WOUT); g.K = 1024;
  EpiX1 E{p};
  pg8::gemm_phase((PG8_LAS unsigned char*)smem, g, S, E);
}

struct EpiH {
  unsigned char* ws;
  __device__ __forceinline__ void operator()(const acc8_t& acc, const pg8::Unit& u, int wr, int wc, int fr, int fq) const {
    u16* H = (u16*)(ws + OFF_H);
    const float* rss = (const float*)(ws + OFF_ROWSS);
#pragma unroll
    for (int ai = 0; ai < 2; ai++)
#pragma unroll
      for (int m = 0; m < 4; m++) {
        const size_t token = EPI_TOKEN(u, ai, m);
        const float rs = rsqrtf(rss[token] * (1.f / 1024.f) + 1e-6f);
#pragma unroll
        for (int bj = 0; bj < 2; bj++)
#pragma unroll
          for (int n = 0; n < 2; n++) {
            const int f = EPI_COL(u, bj, n);
            const float v0 = fmaxf(acc[ai][bj][m][n][0] * rs, 0.f), v1 = fmaxf(acc[ai][bj][m][n][1] * rs, 0.f);
            const float v2 = fmaxf(acc[ai][bj][m][n][2] * rs, 0.f), v3 = fmaxf(acc[ai][bj][m][n][3] * rs, 0.f);
            uint2 o; o.x = pack2(v0 * v0, v1 * v1); o.y = pack2(v2 * v2, v3 * v3);
            *(uint2*)(H + token * 4096 + f) = o;
          }
      }
  }
};
__device__ void phase6(const Params& p, unsigned char* smem) {
  TileSched S; S.init(16, 16 * 130);
  pg8::Gemm g; g.A = (const u16*)(p.ws + OFF_X1B); g.Bt = (const u16*)(p.ws + OFF_WUP); g.K = 1024;
  EpiH E; E.ws = p.ws;
  pg8::gemm_phase((PG8_LAS unsigned char*)smem, g, S, E);
}

struct EpiY {
  float* out;
  __device__ __forceinline__ void operator()(const acc8_t& acc, const pg8::Unit& u, int wr, int wc, int fr, int fq) const {
#pragma unroll
    for (int ai = 0; ai < 2; ai++)
#pragma unroll
      for (int m = 0; m < 4; m++) {
        const size_t token = EPI_TOKEN(u, ai, m);
#pragma unroll
        for (int bj = 0; bj < 2; bj++)
#pragma unroll
          for (int n = 0; n < 2; n++) {
            float* yp = out + O_Y + token * 1024 + EPI_COL(u, bj, n);
            float4 y = *(const float4*)yp;
            y.x += acc[ai][bj][m][n][0]; y.y += acc[ai][bj][m][n][1]; y.z += acc[ai][bj][m][n][2]; y.w += acc[ai][bj][m][n][3];
            *(float4*)yp = y;
          }
      }
  }
};

constexpr size_t OFF_PART = OFF_XN;
__device__ void phase7(const Params& p, unsigned char* smem) {
  GemmSmem& sm = *(GemmSmem*)smem;
  unsigned char* ws = p.ws;
  const int tid = threadIdx.x, lane = tid & 63, wave = tid >> 6;
  const int r = lane & 31, h = lane >> 5;
  {
    TileSched S; S.init(4, 4 * 128);
    pg8::Gemm g; g.A = (const u16*)(ws + OFF_H); g.Bt = (const u16*)(ws + OFF_WDN); g.K = 4096;
    EpiY E; E.out = p.out;
    pg8::gemm_phase((PG8_LAS unsigned char*)smem, g, S, E);
  }
  for (int s = blockIdx.x; s < 128; s += gridDim.x) {
    const int tile = s >> 3, ks = s & 7;
    const int ft = tile & 7, tt = 128 + (tile >> 3);
    f32x16 acc[2][2];
    zero_acc(acc);
    gemm_kloop<512>((const u16*)(ws + OFF_WDN) + (size_t)ft * 128 * 4096 + ks * 512, 4096, (const u16*)(ws + OFF_H) + (size_t)tt * 256 * 4096 + ks * 512, 4096, acc, sm, tid);
    float* part = (float*)(ws + OFF_PART) + (size_t)s * 256 * 128;
#pragma unroll
    for (int tn = 0; tn < 2; tn++) {
      const int tl = (wave >> 1) * 64 + tn * 32 + r;
#pragma unroll
      for (int fm = 0; fm < 2; fm++)
#pragma unroll
        for (int q4 = 0; q4 < 4; q4++) {
          const int fl = (wave & 1) * 64 + fm * 32 + q4 * 8 + 4 * h;
          *(float4*)(part + (size_t)tl * 128 + fl) = make_float4(acc[fm][tn][q4 * 4 + 0], acc[fm][tn][q4 * 4 + 1], acc[fm][tn][q4 * 4 + 2], acc[fm][tn][q4 * 4 + 3]);
        }
    }
  }
}

__device__ void phase8(const Params& p, unsigned char* smem) {
  unsigned char* ws = p.ws;
  const float* part = (const float*)(ws + OFF_PART);
  const int gtid = blockIdx.x * blockDim.x + threadIdx.x, gsz = gridDim.x * blockDim.x;
  for (int i = gtid; i < 16 * 256 * 32; i += gsz) {
    const int f4 = i & 31, tl = (i >> 5) & 255, tile = i >> 13;
    const int ft = tile & 7, tt = 128 + (tile >> 3);
    float* yp = p.out + O_Y + (size_t)(tt * 256 + tl) * 1024 + ft * 128 + f4 * 4;
    float4 y = *(const float4*)yp;
#pragma unroll
    for (int ks = 0; ks < 8; ks++) {
      const float4 v = *(const float4*)(part + ((size_t)(tile * 8 + ks) * 256 + tl) * 128 + f4 * 4);
      y.x += v.x; y.y += v.y; y.z += v.z; y.w += v.w;
    }
    *(float4*)yp = y;
  }
}

__global__ void __launch_bounds__(512) mega(Params p, int ph_lo, int ph_hi) {
  __shared__ __align__(16) unsigned char smem[SMEM_BYTES];
#ifndef PROBE_DUP
#define PROBE_DUP -1
#endif
#ifndef PROBE_KLOOP
#define PROBE_KLOOP 0
#endif
#define RUN_PHASE(k, fn)                                  \
  if (ph_lo <= k && k <= ph_hi) {                         \
    if (k == PROBE_DUP) { fn(p, smem); cg::this_grid().sync(); } \
    fn(p, smem);                                          \
    if (k < ph_hi) cg::this_grid().sync();                \
  }
  RUN_PHASE(0, phase0)
  RUN_PHASE(1, phase1)
#if PROBE_REP2
  if (ph_lo <= 2 && 2 <= ph_hi) { for (int rep = 0; rep < PROBE_REP2; rep++) { phase2(p, smem); cg::this_grid().sync(); } }
#else
  RUN_PHASE(2, phase2)
#endif
#if PROBE_DRY3
  if (ph_lo <= 3 && 3 <= ph_hi) { phase3(p, smem, true); cg::this_grid().sync(); }
#endif
  RUN_PHASE(3, phase3)
  RUN_PHASE(4, phase4)
  RUN_PHASE(5, phase5)
  RUN_PHASE(6, phase6)
  RUN_PHASE(7, phase7)
  RUN_PHASE(8, phase8)
}

extern "C" void kernel_launch(void* const* d_in, const int* in_sizes, int n_in, void* d_out, int out_size,
                              void* d_ws, size_t ws_size, hipStream_t stream) {
  Params p{};
  for (int i = 0; i < 21; i++) p.in[i] = (const float*)d_in[i];
  p.out = (float*)d_out;
  p.ws = (unsigned char*)d_ws;
  static int grid_blocks = 0;
  if (!grid_blocks) {
    int dev = 0, cus = 0, per_cu = 0;
    hipGetDevice(&dev);
    hipDeviceGetAttribute(&cus, hipDeviceAttributeMultiprocessorCount, dev);
    hipOccupancyMaxActiveBlocksPerMultiprocessor(&per_cu, mega, 512, 0);
    if (per_cu < 1) per_cu = 1;
    grid_blocks = cus * per_cu;
  }
#if MULTI_LAUNCH
  for (int ph = 0; ph < 9; ph++) {
    hipLaunchKernelGGL(mega, dim3(grid_blocks), dim3(512), 0, stream, p, ph, ph);
  }
#else
  int lo = 0, hi = 8;
  void* args[] = {&p, &lo, &hi};
  hipError_t e = hipLaunchCooperativeKernel((void*)mega, dim3(grid_blocks), dim3(512), args, 0, stream);
  if (e != hipSuccess) fprintf(stderr, "cooperative launch failed: %s (grid %d)\n", hipGetErrorString(e), grid_blocks);
#endif
}
```

```cpp
#include <hip/hip_runtime.h>
#include <hip/hip_cooperative_groups.h>
#include <stdint.h>
#include <cstdio>
namespace cg = cooperative_groups;

typedef __attribute__((ext_vector_type(8))) short bf16x8;
typedef __attribute__((ext_vector_type(16))) float f32x16;
typedef __attribute__((ext_vector_type(4))) float f32x4;
typedef unsigned short u16;
typedef unsigned long long u64;

#ifndef PROBE_KLOOP
#define PROBE_KLOOP 0
#endif
#ifndef PROBE_REP2
#define PROBE_REP2 0
#endif
#ifndef PROBE_DRY3
#define PROBE_DRY3 0
#endif
#ifndef MULTI_LAUNCH
#define MULTI_LAUNCH 0
#endif

#define NTOK 33280
#define NPROMPT 32768
#define DM 1024
#define DFF 4096
#define NIN 5888
#define LOG2E 1.4426950408889634f

constexpr size_t AL(size_t x) { return (x + 255) & ~(size_t)255; }
constexpr size_t OFF_WIN = 0;
constexpr size_t OFF_WOA = OFF_WIN + AL((size_t)NIN * 1024 * 2);
constexpr size_t OFF_WOB = OFF_WOA + AL((size_t)1024 * 512 * 2);
constexpr size_t OFF_WOUT = OFF_WOB + AL((size_t)1024 * 512 * 2);
constexpr size_t OFF_WUP = OFF_WOUT + AL((size_t)1024 * 1024 * 2);
constexpr size_t OFF_WDN = OFF_WUP + AL((size_t)4096 * 1024 * 2);
constexpr size_t OFF_CS = OFF_WDN + AL((size_t)4096 * 1024 * 2);
constexpr size_t OFF_ROWSS = OFF_CS + AL((size_t)8192 * 8 * 8);
constexpr size_t OFF_XN = OFF_ROWSS + AL((size_t)NTOK * 4);
constexpr size_t OFF_MASKP = OFF_XN;
constexpr size_t OFF_MASKS = OFF_MASKP + (size_t)NPROMPT * 128 * 8;
constexpr size_t OFF_X1B = OFF_XN;
constexpr size_t OFF_Z = OFF_XN + AL((size_t)NTOK * 1024 * 2);
constexpr size_t OFF_QA = OFF_Z;
constexpr size_t OFF_QB = OFF_QA + AL((size_t)NTOK * 512 * 2);
constexpr size_t OFF_QI = OFF_QB + AL((size_t)NTOK * 512 * 2);
constexpr size_t OFF_GA = OFF_QI + AL((size_t)NTOK * 512 * 2);
constexpr size_t OFF_GB = OFF_GA + AL((size_t)NTOK * 1024 * 2);
constexpr size_t OFF_WI = OFF_GB + AL((size_t)NTOK * 1024 * 2);
constexpr size_t OFF_KAP = OFF_WI + AL((size_t)NTOK * 8 * 4);
constexpr size_t OFF_KAS = OFF_KAP + AL((size_t)4 * 8 * 8192 * 64 * 2);
constexpr size_t OFF_VAP = OFF_KAS + AL((size_t)8 * 8 * 1088 * 64 * 2);
constexpr size_t OFF_VAS = OFF_VAP + AL((size_t)4 * 8 * 8192 * 64 * 2);
constexpr size_t OFF_KIP = OFF_VAS + AL((size_t)8 * 8 * 1088 * 64 * 2);
constexpr size_t OFF_KIS = OFF_KIP + AL((size_t)4 * 8192 * 64 * 2);
constexpr size_t OFF_KBP = OFF_KIS + AL((size_t)8 * 1088 * 64 * 2);
constexpr size_t OFF_KBS = OFF_KBP + AL((size_t)4 * 8 * 8192 * 64 * 2);
constexpr size_t OFF_VBP = OFF_KBS + AL((size_t)8 * 8 * 576 * 64 * 2);
constexpr size_t OFF_VBS = OFF_VBP + AL((size_t)4 * 8 * 8192 * 64 * 2);
constexpr size_t OFF_END = OFF_VBS + AL((size_t)8 * 8 * 576 * 64 * 2);
constexpr size_t OFF_M = OFF_KAP;
constexpr size_t OFF_H = OFF_Z;
static_assert(OFF_MASKS + (size_t)512 * 32 * 8 <= OFF_Z, "mask overlay");
static_assert(OFF_M + (size_t)NTOK * 1024 * 2 <= OFF_END, "M overlay");
static_assert(OFF_H + (size_t)NTOK * 4096 * 2 <= OFF_END, "H overlay");
static_assert(OFF_END <= (size_t)512 * 1024 * 1024, "ws budget");

constexpr size_t O_Y = 0;
constexpr size_t O_KAP = (size_t)NTOK * 1024;
constexpr size_t O_VAP = O_KAP + (size_t)4 * 8192 * 512;
constexpr size_t O_KIP = O_VAP + (size_t)4 * 8192 * 512;
constexpr size_t O_KBP = O_KIP + (size_t)4 * 8192 * 64;
constexpr size_t O_VBP = O_KBP + (size_t)4 * 512 * 512;
constexpr size_t O_KAS = O_VBP + (size_t)4 * 512 * 512;
constexpr size_t O_VAS = O_KAS + (size_t)8 * 64 * 512;
constexpr size_t O_KIS = O_VAS + (size_t)8 * 64 * 512;
constexpr size_t O_KBS = O_KIS + (size_t)8 * 64 * 64;
constexpr size_t O_VBS = O_KBS + (size_t)8 * 64 * 512;

struct Params {
  const float* in[21];
  float* out;
  unsigned char* ws;
};

__device__ __forceinline__ u16 f2bf(float f) {
  uint32_t u = __float_as_uint(f);
  u += 0x7FFFu + ((u >> 16) & 1u);
  return (u16)(u >> 16);
}
typedef __bf16 bf16v2 __attribute__((ext_vector_type(2)));
typedef float f32v2 __attribute__((ext_vector_type(2)));
__device__ __forceinline__ uint32_t pack2(float a, float b) {
  f32v2 v = {a, b};
  bf16v2 r = __builtin_convertvector(v, bf16v2);
  return __builtin_bit_cast(uint32_t, r);
}
__device__ __forceinline__ float bf2f(u16 v) { return __uint_as_float(((uint32_t)v) << 16); }
__device__ __forceinline__ float bflo(uint32_t v) { return __uint_as_float(v << 16); }
__device__ __forceinline__ float bfhi(uint32_t v) { return __uint_as_float(v & 0xFFFF0000u); }
__device__ __forceinline__ f32x16 mfma32(bf16x8 a, bf16x8 b, f32x16 c) {
  return __builtin_amdgcn_mfma_f32_32x32x16_bf16(a, b, c, 0, 0, 0);
}
__device__ __forceinline__ f32x4 mfma16(bf16x8 a, bf16x8 b, f32x4 c) {
  return __builtin_amdgcn_mfma_f32_16x16x32_bf16(a, b, c, 0, 0, 0);
}
__device__ __forceinline__ bf16x8 as_bf8(uint4 v) {
  union { uint4 u; bf16x8 b; } x; x.u = v; return x.b;
}
__device__ __forceinline__ const float* xrow(const Params& p, int token) {
  return token < NPROMPT ? p.in[0] + (size_t)token * 1024 : p.in[1] + (size_t)(token - NPROMPT) * 1024;
}

__device__ __forceinline__ float xsum16(float v) {
  auto r = __builtin_amdgcn_permlane16_swap(__float_as_uint(v), __float_as_uint(v), false, false);
  return __uint_as_float(r[0]) + __uint_as_float(r[1]);
}
__device__ __forceinline__ float xsum32(float v) {
  auto r = __builtin_amdgcn_permlane32_swap(__float_as_uint(v), __float_as_uint(v), false, false);
  return __uint_as_float(r[0]) + __uint_as_float(r[1]);
}
__device__ __forceinline__ float xother32(float v, bool lower_half) {
  auto r = __builtin_amdgcn_permlane32_swap(__float_as_uint(v), __float_as_uint(v), false, false);
  return lower_half ? __uint_as_float(r[1]) : __uint_as_float(r[0]);
}

#define SMEM_BYTES (131072 + 8192)

struct GemmSmem { u16 A[2][128][72]; u16 B[2][256][72]; };

#define GEMM_MMA(cb, kk)                                                               \
  {                                                                                    \
    bf16x8 a0_ = *(const bf16x8*)&sm.A[cb][wf * 64 + r][(kk) * 16 + h * 8];            \
    bf16x8 a1_ = *(const bf16x8*)&sm.A[cb][wf * 64 + 32 + r][(kk) * 16 + h * 8];       \
    bf16x8 b0_ = *(const bf16x8*)&sm.B[cb][wt * 64 + r][(kk) * 16 + h * 8];            \
    bf16x8 b1_ = *(const bf16x8*)&sm.B[cb][wt * 64 + 32 + r][(kk) * 16 + h * 8];       \
    acc[0][0] = mfma32(a0_, b0_, acc[0][0]);                                           \
    acc[0][1] = mfma32(a0_, b1_, acc[0][1]);                                           \
    acc[1][0] = mfma32(a1_, b0_, acc[1][0]);                                           \
    acc[1][1] = mfma32(a1_, b1_, acc[1][1]);                                           \
  }
#define GEMM_STEP(cb, A0, A1, B0, B1, B2, B3, dowrite, doload, tload)                  \
  {                                                                                    \
    GEMM_MMA(cb, 0)                                                                    \
    if (dowrite) { *(uint4*)&sm.A[cb ^ 1][crow][ccol] = A0; *(uint4*)&sm.A[cb ^ 1][crow + 64][ccol] = A1; } \
    __builtin_amdgcn_sched_barrier(0);                                                 \
    GEMM_MMA(cb, 1)                                                                    \
    if (dowrite) { *(uint4*)&sm.B[cb ^ 1][crow][ccol] = B0; *(uint4*)&sm.B[cb ^ 1][crow + 64][ccol] = B1; } \
    __builtin_amdgcn_sched_barrier(0);                                                 \
    GEMM_MMA(cb, 2)                                                                    \
    if (dowrite) { *(uint4*)&sm.B[cb ^ 1][crow + 128][ccol] = B2; *(uint4*)&sm.B[cb ^ 1][crow + 192][ccol] = B3; } \
    __builtin_amdgcn_sched_barrier(0);                                                 \
    GEMM_MMA(cb, 3)                                                                    \
    if (doload) {                                                                      \
      const u16* ap_ = ap + (size_t)(tload) * 64; const u16* bp_ = bp + (size_t)(tload) * 64; \
      A0 = *(const uint4*)(ap_); A1 = *(const uint4*)(ap_ + as64);                     \
      B0 = *(const uint4*)(bp_); B1 = *(const uint4*)(bp_ + bs64); B2 = *(const uint4*)(bp_ + 2 * bs64); B3 = *(const uint4*)(bp_ + 3 * bs64); \
    }                                                                                  \
    __syncthreads();                                                                   \
  }

template <int KTOT>
__device__ __forceinline__ void gemm_kloop(const u16* __restrict__ Ag, int lda, const u16* __restrict__ Bg, int ldb,
                                           f32x16 (&acc)[2][2], GemmSmem& sm, int tid) {
  const int lane = tid & 63, wave = tid >> 6;
  const int wf = wave & 1, wt = wave >> 1;
  const int r = lane & 31, h = lane >> 5;
  constexpr int KT = KTOT / 64;
  const int crow = tid >> 3, ccol = (tid & 7) * 8;
  const u16* ap = Ag + (size_t)crow * lda + ccol;
  const u16* bp = Bg + (size_t)crow * ldb + ccol;
  const size_t as64 = (size_t)64 * lda, bs64 = (size_t)64 * ldb;
  uint4 ra0 = *(const uint4*)(ap), ra1 = *(const uint4*)(ap + as64);
  uint4 rb0 = *(const uint4*)(bp), rb1 = *(const uint4*)(bp + bs64), rb2 = *(const uint4*)(bp + 2 * bs64), rb3 = *(const uint4*)(bp + 3 * bs64);
  *(uint4*)&sm.A[0][crow][ccol] = ra0;
  *(uint4*)&sm.A[0][crow + 64][ccol] = ra1;
  *(uint4*)&sm.B[0][crow][ccol] = rb0;
  *(uint4*)&sm.B[0][crow + 64][ccol] = rb1;
  *(uint4*)&sm.B[0][crow + 128][ccol] = rb2;
  *(uint4*)&sm.B[0][crow + 192][ccol] = rb3;
  ra0 = *(const uint4*)(ap + 64); ra1 = *(const uint4*)(ap + 64 + as64);
  rb0 = *(const uint4*)(bp + 64); rb1 = *(const uint4*)(bp + 64 + bs64); rb2 = *(const uint4*)(bp + 64 + 2 * bs64); rb3 = *(const uint4*)(bp + 64 + 3 * bs64);
  __syncthreads();
  for (int kt = 0; kt < KT; kt += 2) {
    GEMM_STEP(0, ra0, ra1, rb0, rb1, rb2, rb3, true, (kt + 2 < KT), kt + 2)
    GEMM_STEP(1, ra0, ra1, rb0, rb1, rb2, rb3, (kt + 2 < KT), (kt + 3 < KT), kt + 3)
  }
}

__device__ __forceinline__ void tile_range(int N, int& lo, int& hi, int& step) {
  if ((gridDim.x & 7) == 0) {
    const int x = blockIdx.x & 7, l = blockIdx.x >> 3;
    lo = (int)((long long)x * N / 8) + l; hi = (int)((long long)(x + 1) * N / 8); step = gridDim.x >> 3;
  } else { lo = blockIdx.x; hi = N; step = gridDim.x; }
}
__device__ __forceinline__ void tile_decode(int i, int NF, int& ft, int& tt) {
  const int full = 128 * NF;
  if (i < full) { const int g = i / (4 * NF); const int rem = i - g * 4 * NF; ft = rem >> 2; tt = 4 * g + (rem & 3); }
  else { const int rem = i - full; ft = rem >> 1; tt = 128 + (rem & 1); }
}

__device__ __forceinline__ void zero_acc(f32x16 (&acc)[2][2]) {
#pragma unroll
  for (int a = 0; a < 2; a++)
#pragma unroll
    for (int b = 0; b < 2; b++)
#pragma unroll
      for (int i = 0; i < 16; i++) acc[a][b][i] = 0.f;
}

namespace pg8 {
#define PG8_LAS __attribute__((address_space(3)))
constexpr int BM = 256, BK = 64, HALF = 128, HTB = HALF * BK * 2, STAGE_BYTES = 8 * HTB;
__device__ __forceinline__ int lds_byte(int r, int c) { const int st = (r >> 4) * 2 + (c >> 5), rr = r & 15, cc = c & 31, ob = rr * 64 + cc * 2; return st * 1024 + (ob ^ (((ob >> 9) & 1) << 5)); }
__device__ __forceinline__ void stage_rc(int b, int& R, int& C) { const int st = b / 1024, sb = b % 1024, swz = sb ^ (((sb >> 9) & 1) << 5); R = (st >> 1) * 16 + swz / 64; C = (st & 1) * 32 + (swz % 64) / 2; }
struct Unit { int pm, pn; };
struct Gemm { const u16* A; const u16* Bt; int K; };

template <class Epi, class Sched>
__device__ __forceinline__ void gemm_phase(PG8_LAS unsigned char* lds, const Gemm g, const Sched& S, const Epi& E) {
    const int tid = threadIdx.x, wid = __builtin_amdgcn_readfirstlane(tid >> 6), lane = tid & 63, wr = wid >> 2, wc = wid & 3, fr = lane & 15, fq = lane >> 4;
    const int K = g.K, nt = K / BK;
    unsigned voffA[2], voffB[2];
#pragma unroll
    for (int i = 0; i < 2; ++i) { int R, C; stage_rc(tid * 16 + i * 8192, R, C); voffA[i] = (unsigned)(R * K + C) * 2u; voffB[i] = voffA[i]; }
    const size_t kstep = (size_t)(BK * 2);
    const size_t hstep = (size_t)HALF * K * 2;
    const size_t tstep = 2 * hstep;
    const unsigned ldsw = (unsigned)wid * 1024u;
    const int aoff = lds_byte(wr * 64 + fr, fq * 8), boff = lds_byte(wc * 32 + fr, fq * 8);
#define PG8_SA(b, h) (((b) * 2 + (h)) * HTB)
#define PG8_SB(b, h) ((4 + (b) * 2 + (h)) * HTB)
#define PG8_STAGE(bufoff, gbase, voff) do { _Pragma("unroll") for (int _i = 0; _i < 2; ++_i) \
        __builtin_amdgcn_global_load_lds((const unsigned*)((const char*)(gbase) + (voff)[_i]), (PG8_LAS unsigned*)(lds + (bufoff) + ldsw + _i * 8192), 16, 0, 0); } while (0)
#define PG8_LDA(dst, b, h) do { _Pragma("unroll") for (int m = 0; m < 4; ++m) _Pragma("unroll") for (int k = 0; k < 2; ++k) dst[m][k] = *(const PG8_LAS bf16x8*)(lds + PG8_SA(b, h) + aoff + m * 2048 + k * 1024); } while (0)
#define PG8_LDB(dst, b, h) do { _Pragma("unroll") for (int n = 0; n < 2; ++n) _Pragma("unroll") for (int k = 0; k < 2; ++k) dst[n][k] = *(const PG8_LAS bf16x8*)(lds + PG8_SB(b, h) + boff + n * 2048 + k * 1024); } while (0)
#define PG8_MMA(ai, bj, At, Bt) do { __builtin_amdgcn_s_setprio(1); _Pragma("unroll") for (int m = 0; m < 4; ++m) _Pragma("unroll") for (int n = 0; n < 2; ++n) _Pragma("unroll") for (int k = 0; k < 2; ++k) \
        acc[ai][bj][m][n] = __builtin_amdgcn_mfma_f32_16x16x32_bf16(Bt[n][k], At[m][k], acc[ai][bj][m][n], 0, 0, 0); __builtin_amdgcn_s_setprio(0); } while (0)
#define PG8_WAIT_V(n) asm volatile("s_waitcnt vmcnt(" #n ")" ::: "memory")
#define PG8_WAIT_L(n) asm volatile("s_waitcnt lgkmcnt(" #n ")" ::: "memory")
#define PG8_BAR __builtin_amdgcn_s_barrier()
#define PG8_SCHED __builtin_amdgcn_sched_barrier(0)
    Unit cur, nxt; int ui = 0;
    if (!S.next(0, cur)) return;
    f32x4 acc[2][2][4][2];
#pragma unroll
    for (int a = 0; a < 2; ++a)
#pragma unroll
        for (int b = 0; b < 2; ++b)
#pragma unroll
            for (int m = 0; m < 4; ++m)
#pragma unroll
                for (int n = 0; n < 2; ++n) acc[a][b][m][n] = (f32x4){0.f, 0.f, 0.f, 0.f};
    bf16x8 At[4][2], B0[2][2], B1[2][2];
    const char* cA = (const char*)g.A + (size_t)cur.pm * tstep; const char* cB = (const char*)g.Bt + (size_t)cur.pn * tstep;
    PG8_STAGE(PG8_SB(0, 0), cB, voffB); PG8_STAGE(PG8_SA(0, 0), cA, voffA); PG8_STAGE(PG8_SB(0, 1), cB + hstep, voffB); PG8_STAGE(PG8_SA(0, 1), cA + hstep, voffA);
    if (wr == 1) PG8_BAR;
    PG8_WAIT_V(4); PG8_BAR;
    PG8_STAGE(PG8_SB(1, 0), cB + kstep, voffB); PG8_STAGE(PG8_SA(1, 0), cA + kstep, voffA); PG8_STAGE(PG8_SB(1, 1), cB + hstep + kstep, voffB);
    PG8_WAIT_V(6); PG8_BAR;
    for (;;) {
        const bool has_next = S.next(ui + 1, nxt);
        const char* nA = has_next ? (const char*)g.A + (size_t)nxt.pm * tstep : cA; const char* nB = has_next ? (const char*)g.Bt + (size_t)nxt.pn * tstep : cB;
        for (int t = 0; t < nt; t += 2) {
            const bool last = (t == nt - 2);
            const char* a1 = cA + (size_t)(t + 1) * kstep;
            const char* a2 = last ? nA : cA + (size_t)(t + 2) * kstep; const char* b2 = last ? nB : cB + (size_t)(t + 2) * kstep;
            const char* a3 = a2 + kstep; const char* b3 = b2 + kstep;
            PG8_LDB(B0, 0, 0); PG8_SCHED; PG8_LDA(At, 0, 0); PG8_STAGE(PG8_SA(1, 1), a1 + hstep, voffA);
            PG8_WAIT_L(8); PG8_BAR; PG8_WAIT_L(0); PG8_MMA(0, 0, At, B0); PG8_BAR; PG8_SCHED;
            PG8_LDB(B1, 0, 1); PG8_STAGE(PG8_SB(0, 0), b2, voffB);
            PG8_BAR; PG8_WAIT_L(0); PG8_MMA(0, 1, At, B1); PG8_BAR;
            PG8_LDA(At, 0, 1); PG8_STAGE(PG8_SA(0, 0), a2, voffA);
            PG8_BAR; PG8_WAIT_L(0); PG8_MMA(1, 0, At, B0); PG8_BAR; PG8_SCHED;
            PG8_STAGE(PG8_SB(0, 1), b2 + hstep, voffB);
            PG8_WAIT_V(6); PG8_BAR; PG8_MMA(1, 1, At, B1); PG8_BAR;
            PG8_LDB(B0, 1, 0); PG8_SCHED; PG8_LDA(At, 1, 0); PG8_STAGE(PG8_SA(0, 1), a2 + hstep, voffA);
            PG8_WAIT_L(8); PG8_BAR; PG8_WAIT_L(0); PG8_MMA(0, 0, At, B0); PG8_BAR; PG8_SCHED;
            PG8_LDB(B1, 1, 1); PG8_STAGE(PG8_SB(1, 0), b3, voffB);
            PG8_BAR; PG8_WAIT_L(0); PG8_MMA(0, 1, At, B1); PG8_BAR;
            PG8_LDA(At, 1, 1); PG8_STAGE(PG8_SA(1, 0), a3, voffA);
            PG8_BAR; PG8_WAIT_L(0); PG8_MMA(1, 0, At, B0); PG8_BAR; PG8_SCHED;
            PG8_STAGE(PG8_SB(1, 1), b3 + hstep, voffB);
            PG8_WAIT_V(6); PG8_BAR; PG8_MMA(1, 1, At, B1); PG8_BAR;
        }
        E(acc, cur, wr, wc, fr, fq);
        if (!has_next) break;
#pragma unroll
        for (int a = 0; a < 2; ++a)
#pragma unroll
            for (int b = 0; b < 2; ++b)
#pragma unroll
                for (int m = 0; m < 4; ++m)
#pragma unroll
                    for (int n = 0; n < 2; ++n) acc[a][b][m][n] = (f32x4){0.f, 0.f, 0.f, 0.f};
        cur = nxt; cA = nA; cB = nB; ++ui;
    }
    PG8_WAIT_V(0);
    if (wr == 0) PG8_BAR;
    PG8_BAR;
#undef PG8_SA
#undef PG8_SB
#undef PG8_STAGE
#undef PG8_LDA
#undef PG8_LDB
#undef PG8_MMA
#undef PG8_WAIT_V
#undef PG8_WAIT_L
#undef PG8_BAR
#undef PG8_SCHED
}
}

struct TileSched {
  int NF, lo, hi, step;
  __device__ __forceinline__ void init(int nf, int ntiles) { NF = nf; tile_range(ntiles, lo, hi, step); }
  __device__ __forceinline__ bool next(int i, pg8::Unit& u) const {
    const int t = lo + i * step;
    if (t >= hi) return false;
    int ft, tt; tile_decode(t, NF, ft, tt); u.pm = tt; u.pn = ft; return true;
  }
};
typedef f32x4 acc8_t[2][2][4][2];

__device__ void tconv_tile(const float* __restrict__ src, int ldsrc, int k0, int nsrc0, int nvalid,
                           u16* __restrict__ dst, int K, int ndst0, const float* __restrict__ gain, float* sm, int tid, int permg = -1) {
  const int nl = tid & 63, kl0 = tid >> 6;
#pragma unroll
  for (int i = 0; i < 8; i++) {
    int kl = kl0 + 8 * i;
    float v = 0.f;
    if (nl < nvalid) {
      v = src[(size_t)(k0 + kl) * ldsrc + nsrc0 + nl];
      if (gain) v *= gain[k0 + kl];
    }
    sm[kl * 65 + nl] = v;
  }
  __syncthreads();
  const int kl = tid & 63, nl0 = tid >> 6;
#pragma unroll
  for (int i = 0; i < 8; i++) {
    int n = nl0 + 8 * i;
    const int drow = permg >= 0 ? 256 * (permg >> 2) + 128 * (n >> 5) + 32 * (permg & 3) + (n & 31) : ndst0 + n;
    dst[(size_t)drow * K + k0 + kl] = f2bf(sm[kl * 65 + n]);
  }
  __syncthreads();
}

__device__ __forceinline__ void tconv_wave(const float* __restrict__ src, int ldsrc, int k0, int nsrc0, int nvalid,
                                           u16* __restrict__ dst, int K, int ndst0, const float* __restrict__ gain, float* smw, int lane, int permg) {
#pragma unroll 1
  for (int kb = 0; kb < 64; kb += 32) {
    float v[32];
#pragma unroll
    for (int i = 0; i < 32; i++) {
      float t = 0.f;
      if (lane < nvalid) {
        t = src[(size_t)(k0 + kb + i) * ldsrc + nsrc0 + lane];
        if (gain) t *= gain[k0 + kb + i];
      }
      v[i] = t;
    }
#pragma unroll
    for (int i = 0; i < 32; i++) smw[(kb + i) * 65 + lane] = v[i];
  }
#pragma unroll 8
  for (int n = 0; n < 64; n++) {
    const int drow = permg >= 0 ? 256 * (permg >> 2) + 128 * (n >> 5) + 32 * (permg & 3) + (n & 31) : ndst0 + n;
    dst[(size_t)drow * K + k0 + lane] = f2bf(smw[lane * 65 + n]);
  }
}

__device__ __forceinline__ int inproj_src_col(int g) {
  if (g < 33) return g * 64;
  if (g < 89) return 2120 + (g - 33) * 64;
  return 2112;
}

__device__ void phase0(const Params& p, unsigned char* smem) {
  const int tid = threadIdx.x;
  unsigned char* ws = p.ws;
  float* smf = (float*)smem;
  const int NT_IN = 92 * 16, NT_OA = 16 * 8, NT_OUT = 16 * 16, NT_UP = 64 * 16, NT_DN = 16 * 64;
  const int total = NT_IN + 2 * NT_OA + NT_OUT + NT_UP + NT_DN;
  {
    const int lane_ = tid & 63, wave_ = tid >> 6;
    float* smw = smf + wave_ * (64 * 65);
    for (int t = blockIdx.x * 8 + wave_; t < total; t += gridDim.x * 8) {
      int u = t;
      const float* src; int ld, k0, nsrc0, nvalid = 64, K, ndst0, permg = -1; u16* dst; const float* gain = nullptr;
      if (u < NT_IN) {
        const int g = u / 16, kb = u % 16;
        src = p.in[8]; ld = 5704; k0 = kb * 64; nsrc0 = inproj_src_col(g); nvalid = g >= 90 ? 0 : (g == 89 ? 8 : 64);
        dst = (u16*)(ws + OFF_WIN); K = 1024; ndst0 = g * 64; permg = g;
      } else if ((u -= NT_IN) < NT_OA) {
        const int g = u / 8, kb = u % 8; src = p.in[15]; ld = 1024; k0 = kb * 64; nsrc0 = g * 64; dst = (u16*)(ws + OFF_WOA); K = 512; ndst0 = g * 64;
      } else if ((u -= NT_OA) < NT_OA) {
        const int g = u / 8, kb = u % 8; src = p.in[16]; ld = 1024; k0 = kb * 64; nsrc0 = g * 64; dst = (u16*)(ws + OFF_WOB); K = 512; ndst0 = g * 64;
      } else if ((u -= NT_OA) < NT_OUT) {
        const int g = u / 16, kb = u % 16; src = p.in[17]; ld = 1024; k0 = kb * 64; nsrc0 = g * 64; dst = (u16*)(ws + OFF_WOUT); K = 1024; ndst0 = g * 64;
      } else if ((u -= NT_OUT) < NT_UP) {
        const int g = u / 16, kb = u % 16; src = p.in[19]; ld = 4096; k0 = kb * 64; nsrc0 = g * 64; dst = (u16*)(ws + OFF_WUP); K = 1024; ndst0 = g * 64; gain = p.in[18];
      } else {
        u -= NT_UP;
        const int g = u / 64, kb = u % 64; src = p.in[20]; ld = 1024; k0 = kb * 64; nsrc0 = g * 64; dst = (u16*)(ws + OFF_WDN); K = 4096; ndst0 = g * 64;
      }
      tconv_wave(src, ld, k0, nsrc0, nvalid, dst, K, ndst0, gain, smw, lane_, permg);
    }
  }
  {
    const int lane = tid & 63, wave = tid >> 6;
    const float* g = p.in[7];
    u16* XN = (u16*)(ws + OFF_XN);
    const int rstride = gridDim.x * 8;
    for (int row = blockIdx.x * 8 + wave; row < NTOK; row += 2 * rstride) {
      const int row2 = row + rstride;
      const bool has2 = row2 < NTOK;
      const float4* xr = (const float4*)xrow(p, row);
      const float4* xr2 = (const float4*)xrow(p, has2 ? row2 : row);
      float4 v[4], w[4];
      float ss = 0.f, ss2 = 0.f;
#pragma unroll
      for (int i = 0; i < 4; i++) { v[i] = xr[lane + 64 * i]; w[i] = xr2[lane + 64 * i]; }
#pragma unroll
      for (int i = 0; i < 4; i++) {
        ss += v[i].x * v[i].x + v[i].y * v[i].y + v[i].z * v[i].z + v[i].w * v[i].w;
        ss2 += w[i].x * w[i].x + w[i].y * w[i].y + w[i].z * w[i].z + w[i].w * w[i].w;
      }
#pragma unroll
      for (int o = 32; o >= 1; o >>= 1) { ss += __shfl_xor(ss, o); ss2 += __shfl_xor(ss2, o); }
      const float rs = rsqrtf(ss * (1.f / 1024.f) + 1e-6f), rs2 = rsqrtf(ss2 * (1.f / 1024.f) + 1e-6f);
#pragma unroll
      for (int i = 0; i < 4; i++) {
        const float4 gg = ((const float4*)g)[lane + 64 * i];
        uint2 o;
        o.x = pack2(v[i].x * rs * gg.x, v[i].y * rs * gg.y);
        o.y = pack2(v[i].z * rs * gg.z, v[i].w * rs * gg.w);
        *(uint2*)(XN + (size_t)row * 1024 + (lane + 64 * i) * 4) = o;
        if (has2) {
          uint2 o2;
          o2.x = pack2(w[i].x * rs2 * gg.x, w[i].y * rs2 * gg.y);
          o2.y = pack2(w[i].z * rs2 * gg.z, w[i].w * rs2 * gg.w);
          *(uint2*)(XN + (size_t)row2 * 1024 + (lane + 64 * i) * 4) = o2;
        }
      }
    }
  }
  const size_t gtid = (size_t)blockIdx.x * blockDim.x + tid;
  const size_t gsz = (size_t)gridDim.x * blockDim.x;
  {
    float2* CS = (float2*)(ws + OFF_CS);
    for (size_t i = gtid; i < 8192 * 8; i += gsz) {
      int pos = (int)(i >> 3), f = (int)(i & 7);
      float inv = powf(500000.0f, -(float)f / 8.0f);
      float ang = (float)pos * inv;
      double rr = (double)ang;
      rr = rr - 6.283185307179586 * rint(rr * 0.15915494309189535);
      float s, c;
      sincosf((float)rr, &s, &c);
      CS[i] = make_float2(c, s);
    }
    float* rss = (float*)(ws + OFF_ROWSS);
    for (size_t i = gtid; i < NTOK; i += gsz) rss[i] = 0.f;
  }
  {
    u16* KAS = (u16*)(ws + OFF_KAS); u16* VAS = (u16*)(ws + OFF_VAS); u16* KIS = (u16*)(ws + OFF_KIS);
    u16* KBS = (u16*)(ws + OFF_KBS); u16* VBS = (u16*)(ws + OFF_VBS);
    const float* cka = p.in[2]; const float* cva = p.in[3]; const float* cki = p.in[4];
    const float* ckb = p.in[5]; const float* cvb = p.in[6];
#pragma unroll 2
    for (size_t i4 = gtid; i4 < (size_t)8 * 1024 * 512 / 4; i4 += gsz) {
      const size_t i = i4 * 4;
      int d = (int)(i & 63), hd = (int)((i >> 6) & 7), j = (int)((i >> 9) & 1023), bs = (int)(i >> 19);
      const float4 kk4 = *(const float4*)(cka + i);
      const float4 vv4 = *(const float4*)(cva + i);
      uint2 ko; ko.x = pack2(kk4.x, kk4.y); ko.y = pack2(kk4.z, kk4.w);
      *(uint2*)(KAS + ((size_t)(bs * 8 + hd) * 1088 + j) * 64 + d) = ko;
      u16* vd = VAS + (size_t)(bs * 8 + hd) * 64 * 1088 + (size_t)(j >> 6) * 4096 + d * 64 + (j & 63);
      vd[0] = f2bf(vv4.x); vd[64] = f2bf(vv4.y); vd[2 * 64] = f2bf(vv4.z); vd[3 * 64] = f2bf(vv4.w);
    }
    for (size_t i4 = gtid; i4 < (size_t)8 * 1024 * 64 / 4; i4 += gsz) {
      const size_t i = i4 * 4;
      int d = (int)(i & 63), j = (int)((i >> 6) & 1023), bs = (int)(i >> 16);
      const float4 kk4 = *(const float4*)(cki + i);
      uint2 ko; ko.x = pack2(kk4.x, kk4.y); ko.y = pack2(kk4.z, kk4.w);
      *(uint2*)(KIS + ((size_t)bs * 1088 + j) * 64 + d) = ko;
    }
#pragma unroll 2
    for (size_t i4 = gtid; i4 < (size_t)8 * 512 * 512 / 4; i4 += gsz) {
      const size_t i = i4 * 4;
      int d = (int)(i & 63), hd = (int)((i >> 6) & 7), j = (int)((i >> 9) & 511), bs = (int)(i >> 18);
      const float4 kk4 = *(const float4*)(ckb + i);
      const float4 vv4 = *(const float4*)(cvb + i);
      uint2 ko; ko.x = pack2(kk4.x, kk4.y); ko.y = pack2(kk4.z, kk4.w);
      *(uint2*)(KBS + ((size_t)(bs * 8 + hd) * 576 + j) * 64 + d) = ko;
      u16* vd = VBS + (size_t)(bs * 8 + hd) * 64 * 576 + (size_t)(j >> 6) * 4096 + d * 64 + (j & 63);
      vd[0] = f2bf(vv4.x); vd[64] = f2bf(vv4.y); vd[2 * 64] = f2bf(vv4.z); vd[3 * 64] = f2bf(vv4.w);
    }
  }
}

template <int AI>
__device__ __forceinline__ void epi_inproj(const Params& p, const acc8_t& acc, int g, int tbase, int fr, int fq) {
  unsigned char* ws = p.ws;
  const bool sample = tbase >= NPROMPT;
  int b, trow;
  if (!sample) { b = tbase >> 13; trow = tbase & 8191; } else { b = (tbase - NPROMPT) >> 6; trow = 0; }
  const float* gain = nullptr; bool rope = false, sig = false;
  u16* bdst = nullptr; size_t brow0 = 0; int bld = 0, bcol = 0;
  u16* vdst = nullptr; int vS = 0, vcol0 = 0;
  float* fdst = nullptr; size_t frow0 = 0; int fld = 0, fcol = 0;
  bool wi = false;
  if (g < 8) { gain = p.in[9]; rope = true; bdst = (u16*)(ws + OFF_QA); brow0 = tbase; bld = 512; bcol = g * 64; }
  else if (g < 16) {
    int hd = g - 8; gain = p.in[10]; rope = true; bld = 64;
    if (!sample) { bdst = (u16*)(ws + OFF_KAP) + (size_t)(b * 8 + hd) * 8192 * 64; brow0 = trow; fdst = p.out + O_KAP; frow0 = tbase; }
    else { bdst = (u16*)(ws + OFF_KAS) + (size_t)(b * 8 + hd) * 1088 * 64; brow0 = 1024; fdst = p.out + O_KAS; frow0 = b * 64; }
    fld = 512; fcol = hd * 64;
  } else if (g < 24) {
    int hd = g - 16;
    if (!sample) { vdst = (u16*)(ws + OFF_VAP) + (size_t)(b * 8 + hd) * 64 * 8192; vS = 8192; vcol0 = trow; fdst = p.out + O_VAP; frow0 = tbase; }
    else { vdst = (u16*)(ws + OFF_VAS) + (size_t)(b * 8 + hd) * 64 * 1088; vS = 1088; vcol0 = 1024; fdst = p.out + O_VAS; frow0 = b * 64; }
    fld = 512; fcol = hd * 64;
  } else if (g < 32) { rope = true; bdst = (u16*)(ws + OFF_QI); brow0 = tbase; bld = 512; bcol = (g - 24) * 64; }
  else if (g == 32) {
    gain = p.in[11]; rope = true; bld = 64; fld = 64;
    if (!sample) { bdst = (u16*)(ws + OFF_KIP) + (size_t)b * 8192 * 64; brow0 = trow; fdst = p.out + O_KIP; frow0 = tbase; }
    else { bdst = (u16*)(ws + OFF_KIS) + (size_t)b * 1088 * 64; brow0 = 1024; fdst = p.out + O_KIS; frow0 = b * 64; }
  } else if (g < 41) { gain = p.in[12]; bdst = (u16*)(ws + OFF_QB); brow0 = tbase; bld = 512; bcol = (g - 33) * 64; }
  else if (g < 49) {
    int hd = g - 41; gain = p.in[13]; bld = 64; fld = 512; fcol = hd * 64;
    if (!sample) {
      bdst = (u16*)(ws + OFF_KBP) + (size_t)(b * 8 + hd) * 8192 * 64; brow0 = trow;
      if (trow >= 7680) { fdst = p.out + O_KBP; frow0 = b * 512 + (trow - 7680); }
    } else { bdst = (u16*)(ws + OFF_KBS) + (size_t)(b * 8 + hd) * 576 * 64; brow0 = 512; fdst = p.out + O_KBS; frow0 = b * 64; }
  } else if (g < 57) {
    int hd = g - 49; fld = 512; fcol = hd * 64;
    if (!sample) {
      vdst = (u16*)(ws + OFF_VBP) + (size_t)(b * 8 + hd) * 64 * 8192; vS = 8192; vcol0 = trow;
      if (trow >= 7680) { fdst = p.out + O_VBP; frow0 = b * 512 + (trow - 7680); }
    } else { vdst = (u16*)(ws + OFF_VBS) + (size_t)(b * 8 + hd) * 64 * 576; vS = 576; vcol0 = 512; fdst = p.out + O_VBS; frow0 = b * 64; }
  } else if (g < 73) { sig = true; bdst = (u16*)(ws + OFF_GA); brow0 = tbase; bld = 1024; bcol = (g - 57) * 64; }
  else if (g < 89) { sig = true; bdst = (u16*)(ws + OFF_GB); brow0 = tbase; bld = 1024; bcol = (g - 73) * 64; }
  else wi = true;

  float4 gg[2][2];
  if (gain) {
#pragma unroll
    for (int bj = 0; bj < 2; bj++)
#pragma unroll
      for (int n = 0; n < 2; n++) gg[bj][n] = *(const float4*)(gain + 32 * bj + 16 * n + 4 * fq);
  }
#pragma unroll
  for (int m = 0; m < 4; m++) {
    const int tl = 16 * m + fr;
    float x[16];
#pragma unroll
    for (int bj = 0; bj < 2; bj++)
#pragma unroll
      for (int n = 0; n < 2; n++)
#pragma unroll
        for (int j = 0; j < 4; j++) x[(bj * 2 + n) * 4 + j] = acc[AI][bj][m][n][j];
    if (wi) {
      if (fq < 2) *(float4*)((float*)(ws + OFF_WI) + (size_t)(tbase + tl) * 8 + 4 * fq) = make_float4(x[0], x[1], x[2], x[3]);
      continue;
    }
    if (gain) {
      float ss = 0.f;
#pragma unroll
      for (int k = 0; k < 16; k++) ss += x[k] * x[k];
      ss = xsum16(ss);
      ss = xsum32(ss);
      const float rs = rsqrtf(ss * (1.f / 64.f) + 1e-6f);
#pragma unroll
      for (int bj = 0; bj < 2; bj++)
#pragma unroll
        for (int n = 0; n < 2; n++) {
          x[(bj * 2 + n) * 4 + 0] *= rs * gg[bj][n].x; x[(bj * 2 + n) * 4 + 1] *= rs * gg[bj][n].y;
          x[(bj * 2 + n) * 4 + 2] *= rs * gg[bj][n].z; x[(bj * 2 + n) * 4 + 3] *= rs * gg[bj][n].w;
        }
    }
    if (rope) {
      const int pos = sample ? 1024 + tl : trow + tl;
      const float4* cs = (const float4*)((const float2*)(ws + OFF_CS) + (size_t)pos * 8 + 4 * (fq & 1));
      const float4 c01 = cs[0], c23 = cs[1];
      const float cc[4] = {c01.x, c01.z, c23.x, c23.z};
      const float sn[4] = {c01.y, c01.w, c23.y, c23.w};
#pragma unroll
      for (int j = 0; j < 4; j++) {
        const float other = xother32(x[j], fq < 2);
        x[j] = (fq < 2) ? x[j] * cc[j] - other * sn[j] : x[j] * cc[j] + other * sn[j];
      }
    }
    if (sig) {
#pragma unroll
      for (int k = 0; k < 16; k++) x[k] = __builtin_amdgcn_rcpf(1.f + __builtin_amdgcn_exp2f(-LOG2E * x[k]));
    }
    if (bdst) {
      u16* d = bdst + (brow0 + tl) * (size_t)bld + bcol;
#pragma unroll
      for (int bj = 0; bj < 2; bj++)
#pragma unroll
        for (int n = 0; n < 2; n++) {
          uint2 o;
          o.x = pack2(x[(bj * 2 + n) * 4 + 0], x[(bj * 2 + n) * 4 + 1]);
          o.y = pack2(x[(bj * 2 + n) * 4 + 2], x[(bj * 2 + n) * 4 + 3]);
          *(uint2*)(d + 32 * bj + 16 * n + 4 * fq) = o;
        }
    }
    if (vdst) {
      const int q = fr & 3;
      const bool q1 = (q & 1) != 0, q2 = (q & 2) != 0;
#define DPPX(v, ctrl) __int_as_float(__builtin_amdgcn_update_dpp(0, __float_as_int(v), ctrl, 0xf, 0xf, true))
#pragma unroll
      for (int bj = 0; bj < 2; bj++)
#pragma unroll
        for (int n = 0; n < 2; n++) {
          float r0 = x[(bj * 2 + n) * 4 + 0], r1 = x[(bj * 2 + n) * 4 + 1], r2 = x[(bj * 2 + n) * 4 + 2], r3 = x[(bj * 2 + n) * 4 + 3];
          { const float s01 = q1 ? r0 : r1, g01 = DPPX(s01, 0xB1); if (q1) r0 = g01; else r1 = g01;
            const float s23 = q1 ? r2 : r3, g23 = DPPX(s23, 0xB1); if (q1) r2 = g23; else r3 = g23; }
          { const float s02 = q2 ? r0 : r2, g02 = DPPX(s02, 0x4E); if (q2) r0 = g02; else r2 = g02;
            const float s13 = q2 ? r1 : r3, g13 = DPPX(s13, 0x4E); if (q2) r1 = g13; else r3 = g13; }
          const int f = 32 * bj + 16 * n + 4 * fq + q;
          uint2 o; o.x = pack2(r0, r1); o.y = pack2(r2, r3);
          *(uint2*)(vdst + (size_t)(vcol0 >> 6) * 4096 + f * 64 + 16 * m + 4 * (fr >> 2)) = o;
        }
#undef DPPX
    }
    if (fdst) {
      float* d = fdst + (frow0 + tl) * (size_t)fld + fcol;
#pragma unroll
      for (int bj = 0; bj < 2; bj++)
#pragma unroll
        for (int n = 0; n < 2; n++)
          { f32x4 v_ = {x[(bj * 2 + n) * 4 + 0], x[(bj * 2 + n) * 4 + 1], x[(bj * 2 + n) * 4 + 2], x[(bj * 2 + n) * 4 + 3]};
            __builtin_nontemporal_store(v_, (f32x4*)(d + 32 * bj + 16 * n + 4 * fq)); }
    }
  }
}

struct EpiInproj {
  const Params& p;
  __device__ __forceinline__ void operator()(const acc8_t& acc, const pg8::Unit& u, int wr, int wc, int fr, int fq) const {
    const int g = u.pn * 4 + wc;
    if (g >= 90) return;
    int fr_ = fr, fq_ = fq;
    asm volatile("" : "+v"(fr_), "+v"(fq_));
    epi_inproj<0>(p, acc, g, u.pm * 256 + 64 * wr, fr_, fq_);
    asm volatile("" : "+v"(fr_), "+v"(fq_));
    epi_inproj<1>(p, acc, g, u.pm * 256 + 128 + 64 * wr, fr_, fq_);
  }
};

__device__ void phase1(const Params& p, unsigned char* smem) {
  TileSched S; S.init(23, 23 * 130);
  pg8::Gemm g; g.A = (const u16*)(p.ws + OFF_XN); g.Bt = (const u16*)(p.ws + OFF_WIN); g.K = 1024;
  EpiInproj E{p};
  pg8::gemm_phase(( PG8_LAS unsigned char*)smem, g, S, E);
}

#define P2_LOADCHUNK(c, A0, B0, A1, B1, A2, B2, A3, B3)                          \
  {                                                                              \
    const u16* kr_ = kbase + (size_t)(c) * 4096;                                 \
    A0 = as_bf8(*(const uint4*)(kr_));        B0 = as_bf8(*(const uint4*)(kr_ + 32));        \
    A1 = as_bf8(*(const uint4*)(kr_ + 1024)); B1 = as_bf8(*(const uint4*)(kr_ + 1024 + 32)); \
    A2 = as_bf8(*(const uint4*)(kr_ + 2048)); B2 = as_bf8(*(const uint4*)(kr_ + 2048 + 32)); \
    A3 = as_bf8(*(const uint4*)(kr_ + 3072)); B3 = as_bf8(*(const uint4*)(kr_ + 3072 + 32)); \
  }
#define P2_RELU(x) __builtin_amdgcn_fmed3f((x), 0.f, __builtin_inff())
#define P2_SCORE(K0, K1, kg)                                                     \
  {                                                                              \
    _Pragma("unroll") for (int pp = 0; pp < 4; pp++) {                           \
      f32x4 a_ = {0.f, 0.f, 0.f, 0.f};                                           \
      a_ = mfma16(qa[pp][0], K0, a_);                                            \
      a_ = mfma16(qa[pp][1], K1, a_);                                            \
      float s_ = wv[pp].x * P2_RELU(a_[0]) + wv[pp].y * P2_RELU(a_[1]) + wv[pp].z * P2_RELU(a_[2]) + wv[pp].w * P2_RELU(a_[3]); \
      { auto r_ = __builtin_amdgcn_permlane16_swap(__float_as_uint(s_), __float_as_uint(s_), false, false); \
        s_ = __uint_as_float(r_[0]) + __uint_as_float(r_[1]); }                  \
      {                                                                          \
        _Float16 hv_ = (_Float16)s_;                                             \
        const int bi_ = (int)__builtin_bit_cast(u16, hv_);                       \
        int sx_; asm("v_bfe_i32 %0, %1, 15, 1" : "=v"(sx_) : "v"(bi_));          \
          \
        sc[2 * pp + (g4 >> 1)][(kg) * 16 + n16] = (u16)(bi_ ^ ((sx_ & 0x7FFF) | 0x8000)); \
      }                                                                          \
    }                                                                            \
  }
#define P2_COUNT(mh_, cnt_)                                                      \
  {                                                                              \
    uint32_t c_ = 0;                                                             \
    _Pragma("unroll") for (int j = 0; j < 16; j++) if (j < nv512) {              \
      c_ += (v[j].x >= mh_) + ((v[j].x << 16) >= mh_);                           \
      c_ += (v[j].y >= mh_) + ((v[j].y << 16) >= mh_);                           \
      c_ += (v[j].z >= mh_) + ((v[j].z << 16) >= mh_);                           \
      c_ += (v[j].w >= mh_) + ((v[j].w << 16) >= mh_);                           \
    }                                                                            \
    _Pragma("unroll") for (int o_ = 32; o_ >= 1; o_ >>= 1) c_ += __shfl_xor(c_, o_); \
    cnt_ = (int)c_;                                                              \
  }

__device__ void phase2(const Params& p, unsigned char* smem) {
  u16 (*sc)[8192] = (u16 (*)[8192])smem;
  unsigned char* ws = p.ws;
  const int tid = threadIdx.x, lane = tid & 63, wave = tid >> 6;
  const int NTILE = 4096 + 64;
  for (int it = blockIdx.x; it < NTILE; it += gridDim.x) {
    const int rr = it >> 8, ww = it & 255;
    const int idx = (rr & 1) ? (rr << 8) + 255 - ww : it;
    int tok0, nvis; const u16* KI; u64* mrow0; int mld;
    if (idx < 4096) {
      int b = idx & 3, j8 = 1023 - (idx >> 2);
      int q0 = j8 * 8;
      tok0 = b * 8192 + q0; nvis = ((q0 >> 6) + 1) * 64;
      KI = (const u16*)(ws + OFF_KIP) + (size_t)b * 8192 * 64;
      mrow0 = (u64*)(ws + OFF_MASKP) + (size_t)tok0 * 128; mld = 128;
    } else {
      int s = idx - 4096; int b = s >> 3, q0 = (s & 7) * 8;
      tok0 = NPROMPT + b * 64 + q0; nvis = 1088;
      KI = (const u16*)(ws + OFF_KIS) + (size_t)b * 1088 * 64;
      mrow0 = (u64*)(ws + OFF_MASKS) + (size_t)(b * 64 + q0) * 32; mld = 32;
    }
    const int nv512 = (nvis + 511) >> 9;
    {
      const int tail = nv512 * 512 - nvis;
      for (int e = tid; e < 8 * tail; e += 512) { int q = e / tail, k = e % tail; sc[q][nvis + k] = 0; }
    }
    const u16* QI = (const u16*)(ws + OFF_QI);
    const float* WI = (const float*)(ws + OFF_WI);
    const int n16 = lane & 15, g4 = lane >> 4;
    bf16x8 qa[4][2]; float4 wv[4];
#pragma unroll
    for (int pp = 0; pp < 4; pp++) {
      const int ql = 2 * pp + (n16 >> 3), hh = n16 & 7;
#pragma unroll
      for (int kh = 0; kh < 2; kh++)
        qa[pp][kh] = as_bf8(*(const uint4*)(QI + (size_t)(tok0 + ql) * 512 + hh * 64 + kh * 32 + 8 * g4));
      wv[pp] = *(const float4*)(WI + (size_t)(tok0 + 2 * pp + (g4 >> 1)) * 8 + 4 * (g4 & 1));
    }
    {
      const int nchunk = nvis >> 6;
      const u16* kbase = KI + (size_t)n16 * 64 + 8 * g4;
      bf16x8 nA0, nB0, nA1, nB1, nA2, nB2, nA3, nB3;
      int c = wave;
      if (c < nchunk) P2_LOADCHUNK(c, nA0, nB0, nA1, nB1, nA2, nB2, nA3, nB3)
      for (; c < nchunk; c += 8) {
        bf16x8 cA0 = nA0, cB0 = nB0, cA1 = nA1, cB1 = nB1, cA2 = nA2, cB2 = nB2, cA3 = nA3, cB3 = nB3;
        if (c + 8 < nchunk) P2_LOADCHUNK(c + 8, nA0, nB0, nA1, nB1, nA2, nB2, nA3, nB3)
        __builtin_amdgcn_sched_barrier(0);
        P2_SCORE(cA0, cB0, c * 4 + 0)
        P2_SCORE(cA1, cB1, c * 4 + 1)
        P2_SCORE(cA2, cB2, c * 4 + 2)
        P2_SCORE(cA3, cB3, c * 4 + 3)
      }
    }
    __syncthreads();
    {
      const u16* my = sc[wave];
      uint32_t T = 0, need_eq = 0;
      if (nvis > 256) {
        uint32_t* hist = (uint32_t*)(smem + 131072) + wave * 256;
        uint32_t Bsel = 0, above = 0;
#pragma unroll
        for (int pass = 0; pass < 2; pass++) {
          *(uint4*)(hist + lane * 4) = make_uint4(0u, 0u, 0u, 0u);
          __builtin_amdgcn_fence(__ATOMIC_RELEASE, "wavefront");
          {
            uint4 cur = *(const uint4*)(my + lane * 8);
            for (int j = 0; j < nv512; j++) {
              uint4 nxt = cur;
              if (j + 1 < nv512) nxt = *(const uint4*)(my + ((j + 1) * 64 + lane) * 8);
#pragma unroll
              for (int e = 0; e < 8; e++) {
                const uint32_t w = (e >> 1) == 0 ? cur.x : ((e >> 1) == 1 ? cur.y : ((e >> 1) == 2 ? cur.z : cur.w));
                const uint32_t k = (e & 1) ? (w >> 16) : (w & 0xFFFFu);
                if (pass == 0) atomicAdd(hist + (k >> 8), 1u);
                else if ((k >> 8) == Bsel) atomicAdd(hist + (k & 255u), 1u);
              }
              cur = nxt;
            }
          }
          __builtin_amdgcn_fence(__ATOMIC_ACQ_REL, "wavefront");
          uint4 hh; { const volatile uint32_t* hv_ = hist + lane * 4; hh.x = hv_[0]; hh.y = hv_[1]; hh.z = hv_[2]; hh.w = hv_[3]; }
          const uint32_t target = 256u - above;
          const uint32_t ssum = hh.x + hh.y + hh.z + hh.w;
          uint32_t suf = ssum;
#pragma unroll
          for (int o = 1; o < 64; o <<= 1) { uint32_t t = __shfl_down(suf, o); if (lane + o < 64) suf += t; }
          const uint32_t excl = suf - ssum;
          const bool hit = (excl < target) && (suf >= target);
          uint32_t bl = 0, ab = 0;
          {
            const uint32_t c3 = excl + hh.w, c2 = c3 + hh.z, c1 = c2 + hh.y;
            if (c3 >= target) { bl = 3; ab = excl; }
            else if (c2 >= target) { bl = 2; ab = c3; }
            else if (c1 >= target) { bl = 1; ab = c2; }
            else { bl = 0; ab = c1; }
          }
          const u64 hb = __ballot(hit);
          const int src = hb ? (int)__builtin_ctzll(hb) : 0;
          const uint32_t binsel = (uint32_t)__shfl((int)(lane * 4 + bl), src);
          const uint32_t absel = (uint32_t)__shfl((int)ab, src);
          if (pass == 0) { Bsel = binsel; above = absel; }
          else { T = (Bsel << 8) | binsel; need_eq = 256u - (above + absel); }
        }
      }
      u64* mrow = mrow0 + (size_t)wave * mld;
      uint32_t eq_seen = 0;
      const u64 ltmask = (1ull << lane) - 1ull;
      uint4 cur = *(const uint4*)(my + lane * 8);
      for (int j = 0; j < nv512; j++) {
        uint4 nxt = cur;
        if (j + 1 < nv512) nxt = *(const uint4*)(my + ((j + 1) * 64 + lane) * 8);
        u64 myword = 0;
#pragma unroll
        for (int e = 0; e < 8; e++) {
          const uint32_t w = (e >> 1) == 0 ? cur.x : ((e >> 1) == 1 ? cur.y : ((e >> 1) == 2 ? cur.z : cur.w));
          const uint32_t k = (e & 1) ? (w >> 16) : (w & 0xFFFFu);
          const bool gt = k > T, eq = (k == T);
          const u64 beq = __ballot(eq);
          const uint32_t rank = __popcll(beq & ltmask);
          const bool sel = gt || (eq && (eq_seen + rank) < need_eq);
          const u64 m = __ballot(sel);
          eq_seen += __popcll(beq);
          if (lane == e) myword = m;
        }
        if (lane < 8) mrow[j * 8 + lane] = myword;
        cur = nxt;
      }
    }
    __syncthreads();
  }
}

struct AttnSmem { u16 K[2][64][72]; u16 VT[2][64][72]; float bias[264]; };

__device__ __forceinline__ void attn_tile(const bool BAND, AttnSmem& sm, u16* Qg, int qtok0, int hd, int nw, const u16* __restrict__ Kg,
                          const u16* __restrict__ VTg, int S, int qloc0, const u64* maskrow0, int mld,
                          const float* bias_tab, int tid, const bool dry = false) {
  const int lane = tid & 63, wave = tid >> 6;
  const int r = lane & 31, h = lane >> 5;
  const bool wact = wave < nw;
  const int wq0 = qloc0 + 32 * wave;
  const int cw = wq0 >> 6;
  const int c_first = qloc0 >> 6, c_last = (qloc0 + 32 * (nw - 1)) >> 6;
  const int kt_lo = BAND ? (c_first - 8 > 0 ? c_first - 8 : 0) : 0;
  if (BAND) {
    for (int e = tid; e < 257; e += 512) sm.bias[e] = bias_tab[e * 8 + hd] * LOG2E;
  }
  bf16x8 qf0, qf1, qf2, qf3;
  u16* qrow = Qg + (size_t)(qtok0 + 32 * wave + r) * 512 + hd * 64;
  const float csc = 0.125f * LOG2E;
  if (wact) {
#define LOADQ(dst, kk)                                                              \
    { uint4 t_ = *(const uint4*)(qrow + (kk) * 16 + h * 8);                          \
      t_.x = pack2(bflo(t_.x) * csc, bfhi(t_.x) * csc); t_.y = pack2(bflo(t_.y) * csc, bfhi(t_.y) * csc); \
      t_.z = pack2(bflo(t_.z) * csc, bfhi(t_.z) * csc); t_.w = pack2(bflo(t_.w) * csc, bfhi(t_.w) * csc); \
      dst = as_bf8(t_); }
    LOADQ(qf0, 0) LOADQ(qf1, 1) LOADQ(qf2, 2) LOADQ(qf3, 3)
#undef LOADQ
  }
  const bool usemask = !BAND && wact;
  const u64* mrow = usemask ? maskrow0 + (size_t)(32 * wave + r) * mld + 4 * h : nullptr;
  u64 mw0 = 0, mw1 = 0, mw2 = 0, mw3 = 0, nx0 = 0, nx1 = 0, nx2 = 0, nx3 = 0;
  if (usemask) { nx0 = mrow[0]; nx1 = mrow[1]; nx2 = mrow[2]; nx3 = mrow[3]; }
  f32x16 o0, o1;
#pragma unroll
  for (int i = 0; i < 16; i++) { o0[i] = 0.f; o1[i] = 0.f; }
  float lsum = 0.f;
  const int lrow = tid >> 3, lcol = (tid & 7) * 8;
  const u16* kptr = Kg + (size_t)(kt_lo * 64 + lrow) * 64 + lcol;
  const u16* vptr = VTg + (size_t)kt_lo * 4096 + lrow * 64 + lcol;
  uint4 kv = *(const uint4*)kptr;
  uint4 vv = *(const uint4*)vptr;
  *(uint4*)&sm.K[0][lrow][lcol] = kv;
  *(uint4*)&sm.VT[0][lrow][lcol] = vv;
  if (kt_lo < c_last) {
    kptr += 64 * 64; vptr += 4096;
    kv = *(const uint4*)kptr;
    vv = *(const uint4*)vptr;
  }
  __syncthreads();
  for (int kt = kt_lo; kt <= c_last; kt++) {
    const int cur = (kt - kt_lo) & 1;
    if (kt < c_last) {
      *(uint4*)&sm.K[cur ^ 1][lrow][lcol] = kv;
      *(uint4*)&sm.VT[cur ^ 1][lrow][lcol] = vv;
      if (kt + 1 < c_last) {
        kptr += 64 * 64; vptr += 4096;
        kv = *(const uint4*)kptr;
        vv = *(const uint4*)vptr;
      }
    }
    if (usemask) {
      if ((kt & 7) == 0) { mw0 = nx0; mw1 = nx1; mw2 = nx2; mw3 = nx3; }
      if ((kt & 7) == 1 && kt + 7 <= cw) {
        const u64* mn = mrow + ((kt >> 3) + 1) * 8;
        nx0 = mn[0]; nx1 = mn[1]; nx2 = mn[2]; nx3 = mn[3];
      }
    }
    __builtin_amdgcn_sched_barrier(0);
    const bool act = wact && kt <= cw && (!BAND || kt >= cw - 8);
    if (act) {
      const int bsh = (kt & 7) * 8;
      uint32_t mb[4];
      mb[0] = (uint32_t)(mw0 >> bsh) & 0xFFu; mb[1] = (uint32_t)(mw1 >> bsh) & 0xFFu;
      mb[2] = (uint32_t)(mw2 >> bsh) & 0xFFu; mb[3] = (uint32_t)(mw3 >> bsh) & 0xFFu;
#pragma unroll
      for (int sb = 0; sb < 2; sb++) {
        f32x16 s;
#pragma unroll
        for (int i = 0; i < 16; i++) s[i] = 0.f;
        s = mfma32(*(const bf16x8*)&sm.K[cur][sb * 32 + r][0 * 16 + h * 8], qf0, s);
        s = mfma32(*(const bf16x8*)&sm.K[cur][sb * 32 + r][1 * 16 + h * 8], qf1, s);
        s = mfma32(*(const bf16x8*)&sm.K[cur][sb * 32 + r][2 * 16 + h * 8], qf2, s);
        s = mfma32(*(const bf16x8*)&sm.K[cur][sb * 32 + r][3 * 16 + h * 8], qf3, s);
        float pv[16];
        if (BAND) {
          const int qpos = wq0 + r;
          if (kt <= cw - 3) {
            const float bb = sm.bias[256];
#pragma unroll
            for (int i = 0; i < 16; i++) pv[i] = __builtin_amdgcn_exp2f(s[i] + bb);
          } else {
#pragma unroll
            for (int i = 0; i < 16; i++) {
              int kpos = kt * 64 + sb * 32 + (i & 3) + 8 * (i >> 2) + 4 * h;
              int dd = qpos - kpos;
              dd = dd < -128 ? -128 : (dd > 128 ? 128 : dd);
              pv[i] = __builtin_amdgcn_exp2f(s[i] + sm.bias[dd + 128]);
            }
          }
        } else {
#pragma unroll
          for (int i = 0; i < 16; i++) {
            const int bit = sb * 4 + (i >> 2);
            const float e = __builtin_amdgcn_exp2f(s[i]);
            int m;
            asm("v_bfe_i32 %0, %1, %2, 1" : "=v"(m) : "v"(mb[i & 3]), "s"(bit));
            pv[i] = __uint_as_float(__float_as_uint(e) & (uint32_t)m);
          }
        }
#pragma unroll
        for (int i = 0; i < 16; i++) lsum += pv[i];
#pragma unroll
        for (int st = 0; st < 2; st++) {
          union { uint32_t u[4]; bf16x8 b; } pf;
#pragma unroll
          for (int j = 0; j < 4; j++) pf.u[j] = pack2(pv[8 * st + 2 * j], pv[8 * st + 2 * j + 1]);
          union { uint2 u[2]; bf16x8 b; } v0, v1;
          const int kc = sb * 32 + 16 * st + 4 * h;
          v0.u[0] = *(const uint2*)&sm.VT[cur][r][kc];
          v0.u[1] = *(const uint2*)&sm.VT[cur][r][kc + 8];
          v1.u[0] = *(const uint2*)&sm.VT[cur][32 + r][kc];
          v1.u[1] = *(const uint2*)&sm.VT[cur][32 + r][kc + 8];
          o0 = mfma32(v0.b, pf.b, o0);
          o1 = mfma32(v1.b, pf.b, o1);
        }
      }
    }
    __syncthreads();
  }
  if (wact && (!dry || lsum == 12345.678f)) {
    lsum += __shfl_xor(lsum, 32);
    const float inv = 1.f / lsum;
#pragma unroll
    for (int q4 = 0; q4 < 4; q4++) {
      uint2 a, b;
      a.x = pack2(o0[q4 * 4 + 0] * inv, o0[q4 * 4 + 1] * inv);
      a.y = pack2(o0[q4 * 4 + 2] * inv, o0[q4 * 4 + 3] * inv);
      b.x = pack2(o1[q4 * 4 + 0] * inv, o1[q4 * 4 + 1] * inv);
      b.y = pack2(o1[q4 * 4 + 2] * inv, o1[q4 * 4 + 3] * inv);
      *(uint2*)(qrow + q4 * 8 + 4 * h) = a;
      *(uint2*)(qrow + 32 + q4 * 8 + 4 * h) = b;
    }
  }
  __syncthreads();
}

__device__ void phase3(const Params& p, unsigned char* smem, const bool dry = false) {
  AttnSmem& sm = *(AttnSmem*)smem;
  unsigned char* ws = p.ws;
  const int tid = threadIdx.x;
  const int NITEM = 1024 + 1024 + 64 + 64;
  for (int it = blockIdx.x; it < NITEM; it += gridDim.x) {
    bool band; int qtok0, hd, nw, S, qloc0, mld = 0; u16* Qg; const u16* Kg; const u16* VTg; const u64* mrow0 = nullptr;
    if (it < 1024) {
      const int rr = it >> 8, ww = it & 255;
      const int w2 = (rr & 1) ? 255 - ww : ww;
      const int j = 31 - (rr * 8 + (w2 >> 5)), bh = w2 & 31;
      const int b = bh >> 3; hd = bh & 7;
      band = false; Qg = (u16*)(ws + OFF_QA); qtok0 = b * 8192 + j * 256; nw = 8; S = 8192; qloc0 = j * 256;
      Kg = (const u16*)(ws + OFF_KAP) + (size_t)(b * 8 + hd) * 8192 * 64;
      VTg = (const u16*)(ws + OFF_VAP) + (size_t)(b * 8 + hd) * 64 * 8192;
      mrow0 = (const u64*)(ws + OFF_MASKP) + (size_t)(b * 8192 + j * 256) * 128; mld = 128;
    } else if (it < 2048) {
      const int u = it - 1024;
      const int j = u >> 5, bh = u & 31;
      const int b = bh >> 3; hd = bh & 7;
      band = true; Qg = (u16*)(ws + OFF_QB); qtok0 = b * 8192 + j * 256; nw = 8; S = 8192; qloc0 = j * 256;
      Kg = (const u16*)(ws + OFF_KBP) + (size_t)(b * 8 + hd) * 8192 * 64;
      VTg = (const u16*)(ws + OFF_VBP) + (size_t)(b * 8 + hd) * 64 * 8192;
    } else if (it < 2048 + 64) {
      const int u = it - 2048;
      const int b = u >> 3; hd = u & 7;
      band = false; Qg = (u16*)(ws + OFF_QA); qtok0 = NPROMPT + b * 64; nw = 2; S = 1088; qloc0 = 1024;
      Kg = (const u16*)(ws + OFF_KAS) + (size_t)(b * 8 + hd) * 1088 * 64;
      VTg = (const u16*)(ws + OFF_VAS) + (size_t)(b * 8 + hd) * 64 * 1088;
      mrow0 = (const u64*)(ws + OFF_MASKS) + (size_t)(b * 64) * 32; mld = 32;
    } else {
      const int u = it - 2048 - 64;
      const int b = u >> 3; hd = u & 7;
      band = true; Qg = (u16*)(ws + OFF_QB); qtok0 = NPROMPT + b * 64; nw = 2; S = 576; qloc0 = 512;
      Kg = (const u16*)(ws + OFF_KBS) + (size_t)(b * 8 + hd) * 576 * 64;
      VTg = (const u16*)(ws + OFF_VBS) + (size_t)(b * 8 + hd) * 64 * 576;
    }
    attn_tile(band, sm, Qg, qtok0, hd, nw, Kg, VTg, S, qloc0, mrow0, mld, p.in[14], tid, dry);
  }
}

#define EPI_TOKEN(u, ai, m) ((size_t)((u).pm * 256 + 128 * (ai) + 64 * wr + 16 * (m) + fr))
#define EPI_COL(u, bj, n) ((u).pn * 256 + 128 * (bj) + 32 * wc + 16 * (n) + 4 * fq)

struct EpiGateA {
  unsigned char* ws;
  __device__ __forceinline__ void operator()(const acc8_t& acc, const pg8::Unit& u, int wr, int wc, int fr, int fq) const {
    const u16* GA = (const u16*)(ws + OFF_GA); u16* M = (u16*)(ws + OFF_M);
#pragma unroll
    for (int ai = 0; ai < 2; ai++)
#pragma unroll
      for (int m = 0; m < 4; m++) {
        const size_t token = EPI_TOKEN(u, ai, m);
#pragma unroll
        for (int bj = 0; bj < 2; bj++)
#pragma unroll
          for (int n = 0; n < 2; n++) {
            const int f = EPI_COL(u, bj, n);
            const uint2 ga = *(const uint2*)(GA + token * 1024 + f);
            uint2 o;
            o.x = pack2(bflo(ga.x) * acc[ai][bj][m][n][0], bfhi(ga.x) * acc[ai][bj][m][n][1]);
            o.y = pack2(bflo(ga.y) * acc[ai][bj][m][n][2], bfhi(ga.y) * acc[ai][bj][m][n][3]);
            *(uint2*)(M + token * 1024 + f) = o;
          }
      }
  }
};
struct EpiGateB {
  unsigned char* ws;
  __device__ __forceinline__ void operator()(const acc8_t& acc, const pg8::Unit& u, int wr, int wc, int fr, int fq) const {
    const u16* GB = (const u16*)(ws + OFF_GB); u16* M = (u16*)(ws + OFF_M);
#pragma unroll
    for (int ai = 0; ai < 2; ai++)
#pragma unroll
      for (int m = 0; m < 4; m++) {
        const size_t token = EPI_TOKEN(u, ai, m);
#pragma unroll
        for (int bj = 0; bj < 2; bj++)
#pragma unroll
          for (int n = 0; n < 2; n++) {
            const int f = EPI_COL(u, bj, n);
            const uint2 gb = *(const uint2*)(GB + token * 1024 + f);
            const uint2 mo = *(const uint2*)(M + token * 1024 + f);
            uint2 o;
            o.x = pack2(bflo(mo.x) + bflo(gb.x) * acc[ai][bj][m][n][0], bfhi(mo.x) + bfhi(gb.x) * acc[ai][bj][m][n][1]);
            o.y = pack2(bflo(mo.y) + bflo(gb.y) * acc[ai][bj][m][n][2], bfhi(mo.y) + bfhi(gb.y) * acc[ai][bj][m][n][3]);
            *(uint2*)(M + token * 1024 + f) = o;
          }
      }
  }
};
__device__ void phase4(const Params& p, unsigned char* smem) {
  TileSched S; S.init(4, 4 * 130);
  {
    pg8::Gemm g; g.A = (const u16*)(p.ws + OFF_QA); g.Bt = (const u16*)(p.ws + OFF_WOA); g.K = 512;
    EpiGateA E; E.ws = p.ws;
    pg8::gemm_phase((PG8_LAS unsigned char*)smem, g, S, E);
  }
  {
    pg8::Gemm g; g.A = (const u16*)(p.ws + OFF_QB); g.Bt = (const u16*)(p.ws + OFF_WOB); g.K = 512;
    EpiGateB E; E.ws = p.ws;
    pg8::gemm_phase((PG8_LAS unsigned char*)smem, g, S, E);
  }
}

struct EpiX1 {
  const Params& p;
  __device__ __forceinline__ void operator()(const acc8_t& acc, const pg8::Unit& u, int wr, int wc, int fr, int fq) const {
    u16* X1B = (u16*)(p.ws + OFF_X1B);
    float* rss = (float*)(p.ws + OFF_ROWSS);
#pragma unroll
    for (int ai = 0; ai < 2; ai++)
#pragma unroll
      for (int m = 0; m < 4; m++) {
        const int token = (int)EPI_TOKEN(u, ai, m);
        const float* xr = xrow(p, token);
        float ss = 0.f;
#pragma unroll
        for (int bj = 0; bj < 2; bj++)
#pragma unroll
          for (int n = 0; n < 2; n++) {
            const int f = EPI_COL(u, bj, n);
            const float4 xv = *(const float4*)(xr + f);
            const float4 o = make_float4(xv.x + acc[ai][bj][m][n][0], xv.y + acc[ai][bj][m][n][1], xv.z + acc[ai][bj][m][n][2], xv.w + acc[ai][bj][m][n][3]);
            ss += o.x * o.x + o.y * o.y + o.z * o.z + o.w * o.w;
            *(float4*)(p.out + O_Y + (size_t)token * 1024 + f) = o;
            uint2 ob; ob.x = pack2(o.x, o.y); ob.y = pack2(o.z, o.w);
            *(uint2*)(X1B + (size_t)token * 1024 + f) = ob;
          }
        ss = xsum16(ss);
        ss = xsum32(ss);
        if (fq == 0) atomicAdd(rss + token, ss);
      }
  }
};
__device__ void phase5(const Params& p, unsigned char* smem) {
  TileSched S; S.init(4, 4 * 130);
  pg8::Gemm g; g.A = (const u16*)(p.ws + OFF_M); g.Bt = (const u16*)(p.ws + OFF_WOUT); g.K = 1024;
  EpiX1 E{p};
  pg8::gemm_phase((PG8_LAS unsigned char*)smem, g, S, E);
}

struct EpiH {
  unsigned char* ws;
  __device__ __forceinline__ void operator()(const acc8_t& acc, const pg8::Unit& u, int wr, int wc, int fr, int fq) const {
    u16* H = (u16*)(ws + OFF_H);
    const float* rss = (const float*)(ws + OFF_ROWSS);
#pragma unroll
    for (int ai = 0; ai < 2; ai++)
#pragma unroll
      for (int m = 0; m < 4; m++) {
        const size_t token = EPI_TOKEN(u, ai, m);
        const float rs = rsqrtf(rss[token] * (1.f / 1024.f) + 1e-6f);
#pragma unroll
        for (int bj = 0; bj < 2; bj++)
#pragma unroll
          for (int n = 0; n < 2; n++) {
            const int f = EPI_COL(u, bj, n);
            const float v0 = fmaxf(acc[ai][bj][m][n][0] * rs, 0.f), v1 = fmaxf(acc[ai][bj][m][n][1] * rs, 0.f);
            const float v2 = fmaxf(acc[ai][bj][m][n][2] * rs, 0.f), v3 = fmaxf(acc[ai][bj][m][n][3] * rs, 0.f);
            uint2 o; o.x = pack2(v0 * v0, v1 * v1); o.y = pack2(v2 * v2, v3 * v3);
            *(uint2*)(H + token * 4096 + f) = o;
          }
      }
  }
};
__device__ void phase6(const Params& p, unsigned char* smem) {
  TileSched S; S.init(16, 16 * 130);
  pg8::Gemm g; g.A = (const u16*)(p.ws + OFF_X1B); g.Bt = (const u16*)(p.ws + OFF_WUP); g.K = 1024;
  EpiH E; E.ws = p.ws;
  pg8::gemm_phase((PG8_LAS unsigned char*)smem, g, S, E);
}

struct EpiY {
  float* out;
  __device__ __forceinline__ void operator()(const acc8_t& acc, const pg8::Unit& u, int wr, int wc, int fr, int fq) const {
#pragma unroll
    for (int ai = 0; ai < 2; ai++)
#pragma unroll
      for (int m = 0; m < 4; m++) {
        const size_t token = EPI_TOKEN(u, ai, m);
#pragma unroll
        for (int bj = 0; bj < 2; bj++)
#pragma unroll
          for (int n = 0; n < 2; n++) {
            float* yp = out + O_Y + token * 1024 + EPI_COL(u, bj, n);
            float4 y = *(const float4*)yp;
            y.x += acc[ai][bj][m][n][0]; y.y += acc[ai][bj][m][n][1]; y.z += acc[ai][bj][m][n][2]; y.w += acc[ai][bj][m][n][3];
            *(float4*)yp = y;
          }
      }
  }
};

constexpr size_t OFF_PART = OFF_XN;
__device__ void phase7(const Params& p, unsigned char* smem) {
  GemmSmem& sm = *(GemmSmem*)smem;
  unsigned char* ws = p.ws;
  const int tid = threadIdx.x, lane = tid & 63, wave = tid >> 6;
  const int r = lane & 31, h = lane >> 5;
  {
    TileSched S; S.init(4, 4 * 128);
    pg8::Gemm g; g.A = (const u16*)(ws + OFF_H); g.Bt = (const u16*)(ws + OFF_WDN); g.K = 4096;
    EpiY E; E.out = p.out;
    pg8::gemm_phase((PG8_LAS unsigned char*)smem, g, S, E);
  }
  for (int s = blockIdx.x; s < 128; s += gridDim.x) {
    const int tile = s >> 3, ks = s & 7;
    const int ft = tile & 7, tt = 128 + (tile >> 3);
    f32x16 acc[2][2];
    zero_acc(acc);
    gemm_kloop<512>((const u16*)(ws + OFF_WDN) + (size_t)ft * 128 * 4096 + ks * 512, 4096, (const u16*)(ws + OFF_H) + (size_t)tt * 256 * 4096 + ks * 512, 4096, acc, sm, tid);
    float* part = (float*)(ws + OFF_PART) + (size_t)s * 256 * 128;
#pragma unroll
    for (int tn = 0; tn < 2; tn++) {
      const int tl = (wave >> 1) * 64 + tn * 32 + r;
#pragma unroll
      for (int fm = 0; fm < 2; fm++)
#pragma unroll
        for (int q4 = 0; q4 < 4; q4++) {
          const int fl = (wave & 1) * 64 + fm * 32 + q4 * 8 + 4 * h;
          *(float4*)(part + (size_t)tl * 128 + fl) = make_float4(acc[fm][tn][q4 * 4 + 0], acc[fm][tn][q4 * 4 + 1], acc[fm][tn][q4 * 4 + 2], acc[fm][tn][q4 * 4 + 3]);
        }
    }
  }
}

__device__ void phase8(const Params& p, unsigned char* smem) {
  unsigned char* ws = p.ws;
  const float* part = (const float*)(ws + OFF_PART);
  const int gtid = blockIdx.x * blockDim.x + threadIdx.x, gsz = gridDim.x * blockDim.x;
  for (int i = gtid; i < 16 * 256 * 32; i += gsz) {
    const int f4 = i & 31, tl = (i >> 5) & 255, tile = i >> 13;
    const int ft = tile & 7, tt = 128 + (tile >> 3);
    float* yp = p.out + O_Y + (size_t)(tt * 256 + tl) * 1024 + ft * 128 + f4 * 4;
    float4 y = *(const float4*)yp;
#pragma unroll
    for (int ks = 0; ks < 8; ks++) {
      const float4 v = *(const float4*)(part + ((size_t)(tile * 8 + ks) * 256 + tl) * 128 + f4 * 4);
      y.x += v.x; y.y += v.y; y.z += v.z; y.w += v.w;
    }
    *(float4*)yp = y;
  }
}

__global__ void __launch_bounds__(512) mega(Params p, int ph_lo, int ph_hi) {
  __shared__ __align__(16) unsigned char smem[SMEM_BYTES];
#ifndef PROBE_DUP
#define PROBE_DUP -1
#endif
#ifndef PROBE_KLOOP
#define PROBE_KLOOP 0
#endif
#define RUN_PHASE(k, fn)                                  \
  if (ph_lo <= k && k <= ph_hi) {                         \
    if (k == PROBE_DUP) { fn(p, smem); cg::this_grid().sync(); } \
    fn(p, smem);                                          \
    if (k < ph_hi) cg::this_grid().sync();                \
  }
  RUN_PHASE(0, phase0)
  RUN_PHASE(1, phase1)
#if PROBE_REP2
  if (ph_lo <= 2 && 2 <= ph_hi) { for (int rep = 0; rep < PROBE_REP2; rep++) { phase2(p, smem); cg::this_grid().sync(); } }
#else
  RUN_PHASE(2, phase2)
#endif
#if PROBE_DRY3
  if (ph_lo <= 3 && 3 <= ph_hi) { phase3(p, smem, true); cg::this_grid().sync(); }
#endif
  RUN_PHASE(3, phase3)
  RUN_PHASE(4, phase4)
  RUN_PHASE(5, phase5)
  RUN_PHASE(6, phase6)
  RUN_PHASE(7, phase7)
  RUN_PHASE(8, phase8)
}

extern "C" void kernel_launch(void* const* d_in, const int* in_sizes, int n_in, void* d_out, int out_size,
                              void* d_ws, size_t ws_size, hipStream_t stream) {
  Params p{};
  for (int i = 0; i < 21; i++) p.in[i] = (const float*)d_in[i];
  p.out = (float*)d_out;
  p.ws = (unsigned char*)d_ws;
  static int grid_blocks = 0;
  if (!grid_blocks) {
    int dev = 0, cus = 0, per_cu = 0;
    hipGetDevice(&dev);
    hipDeviceGetAttribute(&cus, hipDeviceAttributeMultiprocessorCount, dev);
    hipOccupancyMaxActiveBlocksPerMultiprocessor(&per_cu, mega, 512, 0);
    if (per_cu < 1) per_cu = 1;
    grid_blocks = cus * per_cu;
  }
#if MULTI_LAUNCH
  for (int ph = 0; ph < 9; ph++) {
    hipLaunchKernelGGL(mega, dim3(grid_blocks), dim3(512), 0, stream, p, ph, ph);
  }
#else
  int lo = 0, hi = 8;
  void* args[] = {&p, &lo, &hi};
  hipError_t e = hipLaunchCooperativeKernel((void*)mega, dim3(grid_blocks), dim3(512), args, 0, stream);
  if (e != hipSuccess) fprintf(stderr, "cooperative launch failed: %s (grid %d)\n", hipGetErrorString(e), grid_blocks);
#endif
}
```
